# Optimizing an MI355X kernel written in HIP

```python
import math
import jax, jax.numpy as jnp
from jax import lax
import numpy as np

D_MODEL = 2048
BATCH = 16
SEQ = 2048
DEPTH = 2

DIFF_HEADS = D_MODEL // 256
DIFF_HALF_DIM = 64
DIFF_VDIM = 2 * DIFF_HALF_DIM
DIFF_QK_WIDTH = DIFF_HEADS * 2 * DIFF_HALF_DIM
DIFF_WIDTH = DIFF_HEADS * DIFF_VDIM
DIL_HEADS = D_MODEL // 256
DIL_HEAD_DIM = 128
DIL_WIDTH = DIL_HEADS * DIL_HEAD_DIM
DIL_CONFIGS = ((128, 1), (512, 4), (2048, 16))
BLOCK = 128
MIX_WIDTH = DIFF_WIDTH + DIL_WIDTH
IN_COLS = 2 * DIFF_QK_WIDTH + DIFF_WIDTH + 3 * DIL_WIDTH
MEM_LEN = 256
MEM_HEADS = 4
MEM_HEAD_DIM = D_MODEL // MEM_HEADS
D_FF = 256 * (-(-(8 * D_MODEL // 3) // 256))
CONV_WIDTH = 3
ALPHA = (2 * DEPTH) ** 0.25
BETA = (8 * DEPTH) ** -0.25
LN_EPS = 1e-5
RMS_EPS = 1e-5

kernel_name = "hybrid_diffattn_dilated_deepnorm_block"


def alibi_slopes(n):
    return (2.0 ** (-8.0 * np.arange(1, n + 1) / n)).astype(np.float32)


def layer_norm(x, g, b):
    xf = x.astype(jnp.float32)
    mu = jnp.mean(xf, -1, keepdims=True)
    var = jnp.mean(jnp.square(xf - mu), -1, keepdims=True)
    return ((xf - mu) * lax.rsqrt(var + LN_EPS) * g.astype(jnp.float32) + b.astype(jnp.float32)).astype(x.dtype)


def rms_norm(x, g):
    xf = x.astype(jnp.float32)
    y = xf * lax.rsqrt(jnp.mean(jnp.square(xf), -1, keepdims=True) + RMS_EPS)
    return (y * g.astype(jnp.float32)).astype(x.dtype)


def diff_attention(q, k, v, lam, slopes):
    S = q.shape[1]
    dk = q.shape[-1]
    scale = dk ** -0.5
    outs = []
    for i in range(S // BLOCK):
        q0, kend = i * BLOCK, (i + 1) * BLOCK
        s = jnp.einsum('bqhcd,bkhcd->bhcqk', q[:, q0:kend], k[:, :kend]).astype(jnp.float32) * scale
        dist = (q0 + jnp.arange(BLOCK))[:, None] - jnp.arange(kend)[None, :]
        bias = -slopes[:, None, None, None] * dist.astype(jnp.float32)
        s = jnp.where(dist >= 0, s + bias, -jnp.inf)
        p = jax.nn.softmax(s, axis=-1)
        a = p[:, :, 0] - lam * p[:, :, 1]
        outs.append(jnp.einsum('bhqk,bkhd->bqhd', a.astype(v.dtype), v[:, :kend]))
    return jnp.concatenate(outs, axis=1)


def dilated_branch(q, k, v, slopes, window, dil):
    B, S, H, dh = q.shape
    L = S // dil
    nb = -(-L // BLOCK)
    Lp = nb * BLOCK
    n_back = window // dil
    scale = dh ** -0.5

    def to_sub(t):
        t = t.reshape(B, L, dil, H, dh).transpose(0, 2, 1, 3, 4)
        t = jnp.pad(t, ((0, 0), (0, 0), (0, Lp - L), (0, 0), (0, 0)))
        return t.reshape(B, dil, nb, BLOCK, H, dh)

    def with_prev(t):
        prev = jnp.pad(t, ((0, 0), (0, 0), (1, 0), (0, 0), (0, 0), (0, 0)))[:, :, :-1]
        return jnp.concatenate([prev, t], axis=3)

    qs = to_sub(q)
    kb, vb = with_prev(to_sub(k)), with_prev(to_sub(v))
    s = jnp.einsum('bcnqhd,bcnkhd->bchnqk', qs, kb).astype(jnp.float32) * scale
    qi = jnp.arange(BLOCK)[:, None]
    kj = jnp.arange(2 * BLOCK)[None, :]
    rel = qi + BLOCK - kj
    key_sub = jnp.arange(nb)[:, None, None] * BLOCK - BLOCK + kj[None]
    valid = (rel >= 0) & (rel <= n_back) & (key_sub >= 0)
    bias = -slopes[:, None, None, None] * (rel * dil).astype(jnp.float32)
    s = jnp.where(valid, s + bias, -jnp.inf)
    m = jnp.max(s, -1, keepdims=True)
    e = jnp.exp(s - m)
    l = jnp.sum(e, -1, keepdims=True)
    p = e / l
    lse = (m + jnp.log(l))[..., 0]
    o = jnp.einsum('bchnqk,bcnkhd->bcnqhd', p.astype(v.dtype), vb)
    o = o.reshape(B, dil, Lp, H, dh)[:, :, :L].transpose(0, 2, 1, 3, 4).reshape(B, S, H, dh)
    lse = lse.transpose(0, 1, 3, 4, 2).reshape(B, dil, Lp, H)[:, :, :L].transpose(0, 2, 1, 3).reshape(B, S, H)
    return o, lse


def dilated_attention(q, k, v, slopes):
    outs, lses = [], []
    for window, dil in DIL_CONFIGS:
        o, lse = dilated_branch(q, k, v, slopes, window, dil)
        outs.append(o)
        lses.append(lse)
    w = jax.nn.softmax(jnp.stack(lses, 0), axis=0)
    return jnp.einsum('cbsh,cbshd->bshd', w.astype(q.dtype), jnp.stack(outs, 0))


def hybrid_mixer(x, w_in, w_out, lq1, lk1, lq2, lk2, g_diff, g_dil, layer_idx):
    B, S, _ = x.shape
    proj = x @ w_in
    c1 = DIFF_QK_WIDTH
    c2 = 2 * DIFF_QK_WIDTH
    c3 = c2 + DIFF_WIDTH
    c4 = c3 + DIL_WIDTH
    c5 = c4 + DIL_WIDTH
    dq = proj[..., :c1].reshape(B, S, DIFF_HEADS, 2, DIFF_HALF_DIM)
    dk = proj[..., c1:c2].reshape(B, S, DIFF_HEADS, 2, DIFF_HALF_DIM)
    dv = proj[..., c2:c3].reshape(B, S, DIFF_HEADS, DIFF_VDIM)
    sq = proj[..., c3:c4].reshape(B, S, DIL_HEADS, DIL_HEAD_DIM)
    sk = proj[..., c4:c5].reshape(B, S, DIL_HEADS, DIL_HEAD_DIM)
    sv = proj[..., c5:].reshape(B, S, DIL_HEADS, DIL_HEAD_DIM)

    slopes = jnp.asarray(alibi_slopes(DIFF_HEADS + DIL_HEADS))
    slopes_diff, slopes_dil = slopes[0::2], slopes[1::2]

    lam_init = 0.8 - 0.6 * math.exp(-0.3 * layer_idx)
    f32 = jnp.float32
    lam = (jnp.exp(jnp.sum(lq1.astype(f32) * lk1.astype(f32)))
           - jnp.exp(jnp.sum(lq2.astype(f32) * lk2.astype(f32))) + lam_init)
    o_diff = diff_attention(dq, dk, dv, lam, slopes_diff)
    o_diff = rms_norm(o_diff, g_diff) * (1.0 - lam_init)
    o_dil = rms_norm(dilated_attention(sq, sk, sv, slopes_dil), g_dil)
    o = jnp.concatenate([o_diff.reshape(B, S, DIFF_WIDTH), o_dil.reshape(B, S, DIL_WIDTH)], axis=-1)
    return o @ w_out


def memory_attention(x, mem, w_q, w_kv, w_o):
    B, S, _ = x.shape
    M = mem.shape[1]
    q = (x @ w_q).reshape(B, S, MEM_HEADS, MEM_HEAD_DIM)
    kv = (mem @ w_kv).reshape(B, M, 2, MEM_HEADS, MEM_HEAD_DIM)
    s = jnp.einsum('bshd,bmhd->bhsm', q, kv[:, :, 0]).astype(jnp.float32) * MEM_HEAD_DIM ** -0.5
    p = jax.nn.softmax(s, axis=-1)
    o = jnp.einsum('bhsm,bmhd->bshd', p.astype(x.dtype), kv[:, :, 1]).reshape(B, S, D_MODEL)
    return o @ w_o


def conv_ffn(x, w_up, conv_w, conv_b, w_down):
    S = x.shape[1]
    h = x @ w_up
    hp = jnp.pad(h, ((0, 0), (CONV_WIDTH - 1, 0), (0, 0)))
    h = hp[:, 0:S] * conv_w[0] + hp[:, 1:S + 1] * conv_w[1] + hp[:, 2:S + 2] * conv_w[2] + conv_b
    gate, up = h[..., :D_FF], h[..., D_FF:]
    return (jax.nn.silu(gate) * up) @ w_down


def setup_inputs(seed: int = 0) -> dict:
    key = jax.random.key(seed)
    ks = jax.random.split(key, 32)
    f32 = jnp.float32

    def nrm(k, shape, std):
        return jax.random.normal(k, shape, f32) * std

    d_std = D_MODEL ** -0.5
    x = nrm(ks[0], (BATCH, SEQ, D_MODEL), 1.0)
    mem = nrm(ks[1], (BATCH, MEM_LEN, D_MODEL), 1.0)
    w_in = jnp.concatenate([
        nrm(ks[2], (DEPTH, D_MODEL, 2 * DIFF_QK_WIDTH), d_std),
        nrm(ks[3], (DEPTH, D_MODEL, DIFF_WIDTH), d_std * BETA),
        nrm(ks[4], (DEPTH, D_MODEL, 2 * DIL_WIDTH), d_std),
        nrm(ks[5], (DEPTH, D_MODEL, DIL_WIDTH), d_std * BETA),
    ], axis=-1)
    w_mix_out = nrm(ks[6], (DEPTH, MIX_WIDTH, D_MODEL), MIX_WIDTH ** -0.5 * BETA)
    lambda_q1 = nrm(ks[7], (DEPTH, DIFF_HALF_DIM), 0.1)
    lambda_k1 = nrm(ks[8], (DEPTH, DIFF_HALF_DIM), 0.1)
    lambda_q2 = nrm(ks[9], (DEPTH, DIFF_HALF_DIM), 0.1)
    lambda_k2 = nrm(ks[10], (DEPTH, DIFF_HALF_DIM), 0.1)
    g_diff = 1.0 + nrm(ks[11], (DEPTH, DIFF_VDIM), 0.02)
    g_dil = 1.0 + nrm(ks[12], (DEPTH, DIL_HEAD_DIM), 0.02)
    ln1_g = 1.0 + nrm(ks[13], (DEPTH, D_MODEL), 0.02)
    ln1_b = nrm(ks[14], (DEPTH, D_MODEL), 0.02)
    w_mem_q = nrm(ks[15], (DEPTH, D_MODEL, D_MODEL), d_std)
    w_mem_kv = jnp.concatenate([
        nrm(ks[16], (DEPTH, D_MODEL, D_MODEL), d_std),
        nrm(ks[17], (DEPTH, D_MODEL, D_MODEL), d_std * BETA),
    ], axis=-1)
    w_mem_o = nrm(ks[18], (DEPTH, D_MODEL, D_MODEL), d_std * BETA)
    ln2_g = 1.0 + nrm(ks[19], (DEPTH, D_MODEL), 0.02)
    ln2_b = nrm(ks[20], (DEPTH, D_MODEL), 0.02)
    w_up = nrm(ks[21], (DEPTH, D_MODEL, 2 * D_FF), d_std * BETA)
    conv_w = nrm(ks[22], (DEPTH, CONV_WIDTH, 2 * D_FF), CONV_WIDTH ** -0.5)
    conv_b = nrm(ks[23], (DEPTH, 2 * D_FF), 0.02)
    w_down = nrm(ks[24], (DEPTH, D_FF, D_MODEL), D_FF ** -0.5 * BETA)
    ln3_g = 1.0 + nrm(ks[25], (DEPTH, D_MODEL), 0.02)
    ln3_b = nrm(ks[26], (DEPTH, D_MODEL), 0.02)
    return {"x": x, "mem": mem, "w_in": w_in, "w_mix_out": w_mix_out,
            "lambda_q1": lambda_q1, "lambda_k1": lambda_k1, "lambda_q2": lambda_q2, "lambda_k2": lambda_k2,
            "g_diff": g_diff, "g_dil": g_dil, "ln1_g": ln1_g, "ln1_b": ln1_b,
            "w_mem_q": w_mem_q, "w_mem_kv": w_mem_kv, "w_mem_o": w_mem_o, "ln2_g": ln2_g, "ln2_b": ln2_b,
            "w_up": w_up, "conv_w": conv_w, "conv_b": conv_b, "w_down": w_down, "ln3_g": ln3_g, "ln3_b": ln3_b}


def reference(x, mem, w_in, w_mix_out, lambda_q1, lambda_k1, lambda_q2, lambda_k2, g_diff, g_dil,
              ln1_g, ln1_b, w_mem_q, w_mem_kv, w_mem_o, ln2_g, ln2_b,
              w_up, conv_w, conv_b, w_down, ln3_g, ln3_b):
    h = x
    for l in range(DEPTH):
        h = layer_norm(ALPHA * h + hybrid_mixer(h, w_in[l], w_mix_out[l], lambda_q1[l], lambda_k1[l],
                                                lambda_q2[l], lambda_k2[l], g_diff[l], g_dil[l], l),
                       ln1_g[l], ln1_b[l])
        h = layer_norm(ALPHA * h + memory_attention(h, mem, w_mem_q[l], w_mem_kv[l], w_mem_o[l]),
                       ln2_g[l], ln2_b[l])
        h = layer_norm(ALPHA * h + conv_ffn(h, w_up[l], conv_w[l], conv_b[l], w_down[l]),
                       ln3_g[l], ln3_b[l])
    return h
```

```cpp
#include <hip/hip_runtime.h>
#include <hip/hip_cooperative_groups.h>
#include <cstdio>
#include <cstdint>
namespace cg = cooperative_groups;

#define LAS __attribute__((address_space(3)))
typedef unsigned short bf16_t;
typedef short bf16x8 __attribute__((ext_vector_type(8)));
typedef float f32x4 __attribute__((ext_vector_type(4)));
typedef float f32x2 __attribute__((ext_vector_type(2)));
typedef unsigned u32x4 __attribute__((ext_vector_type(4)));
typedef unsigned u32x2 __attribute__((ext_vector_type(2)));

constexpr int DM = 2048, NB = 16, SEQ = 2048, TOK = NB * SEQ, NIN = 6144, DFF = 5632, NUP = 2 * DFF, MEML = 256, MEMT = NB * MEML;
constexpr int NLAYER = 2;
constexpr float ALPHA_RES = 1.4142135623730951f;
constexpr float LN_EPS = 1e-5f, RMS_EPS = 1e-5f;
constexpr size_t WO_IN = 0, WO_OUT = WO_IN + (size_t)NIN * DM, WO_Q = WO_OUT + (size_t)DM * DM, WO_O = WO_Q + (size_t)DM * DM,
                 WO_UP = WO_O + (size_t)DM * DM, WO_DN = WO_UP + (size_t)NUP * DM, W_LAYER = WO_DN + (size_t)DM * DFF;
constexpr int NCOLS = NIN + DM + NUP, CB_IN = 0, CB_Q = NIN, CB_UP = NIN + DM;
constexpr size_t MiB = 1u << 20;
constexpr size_t WS_CSF = 65536;
constexpr size_t WS_W = 1 * MiB;
constexpr size_t WS_PSTAT = 115 * MiB;
constexpr size_t WS_STATS = 132 * MiB;
constexpr size_t WS_IDENT = 131 * MiB;
constexpr size_t WS_XBB = 136 * MiB;
constexpr size_t WS_XB = 264 * MiB;
constexpr size_t WS_BIG = 392 * MiB;
constexpr size_t WS_MEMB = 776 * MiB, WS_KMEM = 792 * MiB, WS_VT = 808 * MiB;
constexpr size_t WS_RAWH = 824 * MiB, WS_RAWT = 872 * MiB;
constexpr size_t WS_RSUM = 920 * MiB;
constexpr size_t WS_PART1 = 924 * MiB;
constexpr size_t WS_LSE = 988 * MiB;
constexpr size_t WS_KV1 = 992 * MiB;
constexpr size_t WS_END = 1024 * MiB;
#ifndef PROBE_DUP_PRO
#define PROBE_DUP_PRO 0
#endif
#ifndef PROBE_DUP_LN
#define PROBE_DUP_LN 0
#endif
#ifndef PROBE_DUP_UP
#define PROBE_DUP_UP 0
#endif
#ifndef PROBE_SYNCS
#define PROBE_SYNCS 0
#endif
#ifndef PROBE_DUP_ATTN
#define PROBE_DUP_ATTN 0
#endif
#ifndef PROBE_DUP_INPROJ
#define PROBE_DUP_INPROJ 0
#endif
#ifndef ATTN_DIFF_MFMA
#define ATTN_DIFF_MFMA 1
#endif
#ifndef ATTN_DIL_MFMA
#define ATTN_DIL_MFMA 1
#endif

__device__ __forceinline__ float sx(float v, int mask, int lane) { return __int_as_float(__builtin_amdgcn_ds_bpermute((lane ^ mask) << 2, __float_as_int(v))); }
__device__ __forceinline__ float bflo(unsigned w) { return __uint_as_float(w << 16); }
__device__ __forceinline__ float bfhi(unsigned w) { return __uint_as_float(w & 0xffff0000u); }
namespace pg8 {
constexpr int BM = 256, BK = 64, HALF = 128, HTB = HALF * BK * 2, STAGE_BYTES = 8 * HTB, NXCD = 8, WGM = 8;
__host__ __device__ __forceinline__ int lds_byte(int r, int c) { const int st = (r >> 4) * 2 + (c >> 5), rr = r & 15, cc = c & 31, ob = rr * 64 + cc * 2; return st * 1024 + (ob ^ (((ob >> 9) & 1) << 5)); }
__host__ __device__ __forceinline__ void stage_rc(int b, int& R, int& C) { const int st = b / 1024, sb = b % 1024, swz = sb ^ (((sb >> 9) & 1) << 5); R = (st >> 1) * 16 + swz / 64; C = (st & 1) * 32 + (swz % 64) / 2; }
__host__ __device__ __forceinline__ int perm32(int rho) { const int n = rho >> 4, i = rho & 15; return 8 * (i >> 2) + 4 * n + (i & 3); }

struct Unit { int orow, ocol, aux, pad; long a_off, b_off; };
struct Gemm { const bf16_t* A; const bf16_t* Bt; int lda, ldb, K; };

struct Sched2D {
    int nM, nN, nwg, G, c; long aT, bT;
    __device__ void init(int M, int N, int lda, int ldb, int G_, int c_) { nM = M / BM; nN = N / BM; nwg = nM * nN; G = G_; c = c_; aT = (long)BM * lda * 2; bT = (long)BM * ldb * 2; }
    __device__ bool next(int i, Unit& u) const {
        const long L = (long)i * G + c; if (L >= nwg) return false;
        int wgid = (int)L; { const int q = nwg / NXCD, r = nwg % NXCD, xcd = wgid % NXCD, off = wgid / NXCD; wgid = (xcd < r ? xcd * (q + 1) : r * (q + 1) + (xcd - r) * q) + off; }
        const int nig = WGM * nN, gid = wgid / nig, fm = gid * WGM, gsz = (nM - fm) < WGM ? (nM - fm) : WGM;
        const int pm = fm + ((wgid % nig) % gsz), pn = (wgid % nig) / gsz;
        u.orow = pm * BM; u.ocol = pn * BM; u.aux = 0; u.pad = 0; u.a_off = pm * aT; u.b_off = pn * bT; return true;
    }
};
struct SchedKV {
    int G, c; long memb_off, wkv0, wkv1;
    __device__ bool next(int i, Unit& u) const {
        const long L = (long)i * G + c; if (L >= 512) return false;
        const int which = (int)L >> 7, t = (int)L & 127; const long wkv = (which >> 1) ? wkv1 : wkv0; u.aux = which; u.pad = 0;
        if ((which & 1) == 0) { const int pm = t & 15, pn = t >> 4; u.orow = pm * BM; u.ocol = pn * BM; u.a_off = memb_off + (long)pm * BM * DM * 2; u.b_off = wkv + (long)pn * BM * DM * 2; }
        else { const int pm = t & 7, pn = t >> 3; u.orow = pm * BM; u.ocol = pn * BM; u.a_off = wkv + (long)(DM + pm * BM) * DM * 2; u.b_off = memb_off + (long)pn * BM * DM * 2; }
        return true;
    }
};
struct SchedScores {
    int G, c;
    __device__ bool next(int i, Unit& u) const {
        const long L = (long)i * G + c; if (L >= NB * 4 * 8) return false;
        const int b = (int)L / 32, h = ((int)L / 8) % 4, qt = (int)L % 8;
        u.orow = b * SEQ + qt * 256; u.ocol = h * 256; u.aux = h; u.pad = 0;
        u.a_off = ((long)u.orow * DM + h * 512) * 2; u.b_off = ((long)(b * MEML) * DM + h * 512) * 2; return true;
    }
};
struct SchedPV {
    int G, c;
    __device__ bool next(int i, Unit& u) const {
        const long L = (long)i * G + c; if (L >= NB * 4 * 8 * 2) return false;
        const int b = (int)L / 64, h = ((int)L / 16) % 4, qt = ((int)L / 2) % 8, dt = (int)L % 2;
        u.orow = b * SEQ + qt * 256; u.ocol = h * 512 + dt * 256; u.aux = h; u.pad = 0;
        u.a_off = ((long)u.orow * 1024 + h * 256) * 2; u.b_off = ((long)(h * 512 + dt * 256) * MEMT + b * MEML) * 2; return true;
    }
};

__device__ __forceinline__ unsigned cvt_pk_bf16(float lo, float hi) { unsigned r; asm volatile("v_cvt_pk_bf16_f32 %0, %1, %2" : "=v"(r) : "v"(lo), "v"(hi)); return r; }

struct EpiBf16 {
    static constexpr bool PERM = true;
    bf16_t* O; int ldc; float sc;
    __device__ __forceinline__ void operator()(f32x4 (&acc)[2][2][4][2], const Unit& u, int wr, int wc, int fr, int fq) const {
        const int row0 = u.orow + wr * 64 + fr, col0 = u.ocol + wc * 32 + 8 * fq;
#pragma unroll
        for (int ai = 0; ai < 2; ++ai)
#pragma unroll
            for (int m = 0; m < 4; ++m) { bf16_t* rowp = O + (size_t)(row0 + ai * HALF + m * 16) * ldc + col0;
#pragma unroll
                for (int bj = 0; bj < 2; ++bj) { const f32x4 v0 = acc[ai][bj][m][0] * sc, v1 = acc[ai][bj][m][1] * sc;
                    u32x4 w; w.x = cvt_pk_bf16(v0[0], v0[1]); w.y = cvt_pk_bf16(v0[2], v0[3]); w.z = cvt_pk_bf16(v1[0], v1[1]); w.w = cvt_pk_bf16(v1[2], v1[3]);
                    *(u32x4*)(rowp + bj * HALF) = w; } }
    }
};
__device__ __forceinline__ void row_stats(const float* ps, int fq, int lane, float& mu, float& rs) {
    const f32x4* p = (const f32x4*)(ps + fq * 16);
    const f32x4 a = p[0], b = p[1], c = p[2], d = p[3];
    float s = (a[0] + a[2]) + (b[0] + b[2]) + (c[0] + c[2]) + (d[0] + d[2]);
    float q = (a[1] + a[3]) + (b[1] + b[3]) + (c[1] + c[3]) + (d[1] + d[3]);
    s += sx(s, 16, lane); q += sx(q, 16, lane); s += sx(s, 32, lane); q += sx(q, 32, lane);
    mu = s * (1.f / DM); rs = 1.f / sqrtf(q * (1.f / DM) - mu * mu + LN_EPS);
}
template <bool F32OUT>
struct EpiResid {
    static constexpr bool PERM = true;
    float* hout; bf16_t* xb; const float* ps_prev  ; float* ps_new  ; const float* g; const float* b;
    __device__ __forceinline__ void operator()(f32x4 (&acc)[2][2][4][2], const Unit& u, int wr, int wc, int  , int  ) const {
        int lane; asm volatile("v_mbcnt_lo_u32_b32 %0, -1, 0\n\tv_mbcnt_hi_u32_b32 %0, -1, %0" : "=v"(lane));
        const int fr = lane & 15, fq = lane >> 4;
        const int col0 = u.ocol + wc * 32 + 8 * fq, slot = (u.ocol >> 8) * 4 + wc;
        const int rowb = u.orow + wr * 64 + fr;
        float mu[8], rs[8];
#pragma unroll
        for (int it = 0; it < 8; ++it) { const f32x2 st = *(const f32x2*)(ps_prev + (size_t)(rowb + (it >> 2) * HALF + (it & 3) * 16) * 2); mu[it] = st[0]; rs[it] = st[1]; }
        {
            f32x4 gv[2][2], bv[2][2];
#pragma unroll
            for (int bj = 0; bj < 2; ++bj)
#pragma unroll
                for (int n = 0; n < 2; ++n) { gv[bj][n] = *(const f32x4*)(g + col0 + bj * HALF + n * 4) * ALPHA_RES; bv[bj][n] = *(const f32x4*)(b + col0 + bj * HALF + n * 4) * ALPHA_RES; }
            u32x4 hv[2], hn[2];
#pragma unroll
            for (int bj = 0; bj < 2; ++bj) { hv[bj] = *(const u32x4*)(xb + (size_t)rowb * DM + col0 + bj * HALF); hn[bj] = hv[bj]; }
#pragma unroll
            for (int it = 0; it < 8; ++it) {
                const int ai = it >> 2, m = it & 3;
                if (it < 7) { int rown = rowb + ((it + 1) >> 2) * HALF + ((it + 1) & 3) * 16; asm volatile("" : "+v"(rown));
                    const size_t offn = (size_t)rown * DM + col0;
#pragma unroll
                    for (int bj = 0; bj < 2; ++bj) hn[bj] = *(const u32x4*)(xb + offn + bj * HALF); }
                asm volatile("" : "+v"(hv[0]), "+v"(hv[1]));
#pragma unroll
                for (int bj = 0; bj < 2; ++bj) { const f32x4 h0 = (f32x4){bflo(hv[bj].x), bfhi(hv[bj].x), bflo(hv[bj].y), bfhi(hv[bj].y)}, h1 = (f32x4){bflo(hv[bj].z), bfhi(hv[bj].z), bflo(hv[bj].w), bfhi(hv[bj].w)};
                    acc[ai][bj][m][0] = ((h0 - mu[it]) * rs[it]) * gv[bj][0] + bv[bj][0] + acc[ai][bj][m][0];
                    acc[ai][bj][m][1] = ((h1 - mu[it]) * rs[it]) * gv[bj][1] + bv[bj][1] + acc[ai][bj][m][1]; hv[bj] = hn[bj]; }
            }
        }
#pragma unroll
        for (int ai = 0; ai < 2; ++ai)
#pragma unroll
            for (int m = 0; m < 4; ++m) asm volatile("" : "+v"(acc[ai][0][m][0]), "+v"(acc[ai][0][m][1]), "+v"(acc[ai][1][m][0]), "+v"(acc[ai][1][m][1]));
        int rowb2 = rowb; asm volatile("" : "+v"(rowb2));
#pragma unroll
        for (int it = 0; it < 8; ++it) {
            const int ai = it >> 2, m = it & 3; int row = rowb2 + ai * HALF + m * 16; asm volatile("" : "+v"(row)); const size_t off = (size_t)row * DM + col0;
            float s1 = 0.f, s2 = 0.f;
#pragma unroll
            for (int bj = 0; bj < 2; ++bj) { const f32x4 y0 = acc[ai][bj][m][0], y1 = acc[ai][bj][m][1];
                if (F32OUT) { *(f32x4*)(hout + off + bj * HALF) = y0; *(f32x4*)(hout + off + bj * HALF + 4) = y1; }
                else { s1 += ((y0[0] + y0[1]) + (y0[2] + y0[3])) + ((y1[0] + y1[1]) + (y1[2] + y1[3]));
                    s2 += ((y0[0] * y0[0] + y0[1] * y0[1]) + (y0[2] * y0[2] + y0[3] * y0[3])) + ((y1[0] * y1[0] + y1[1] * y1[1]) + (y1[2] * y1[2] + y1[3] * y1[3]));
                    u32x4 w; w.x = cvt_pk_bf16(y0[0], y0[1]); w.y = cvt_pk_bf16(y0[2], y0[3]); w.z = cvt_pk_bf16(y1[0], y1[1]); w.w = cvt_pk_bf16(y1[2], y1[3]); *(u32x4*)(xb + off + bj * HALF) = w; } }
            if (!F32OUT) { s1 += sx(s1, 16, lane); s2 += sx(s2, 16, lane); s1 += sx(s1, 32, lane); s2 += sx(s2, 32, lane);
                if (fq == 0) { f32x2 o2; o2[0] = s1; o2[1] = s2; *(f32x2*)(ps_new + (size_t)row * 64 + slot * 2) = o2; } }
        }
    }
};
struct EpiBf16A {
    static constexpr bool PERM = true;
    bf16_t* O; int ldc; const float* ps; const float* cs; const float* bw;
    __device__ __forceinline__ void operator()(f32x4 (&acc)[2][2][4][2], const Unit& u, int wr, int wc, int fr, int fq) const {
        const int row0 = u.orow + wr * 64 + fr, col0 = u.ocol + wc * 32 + 8 * fq;
        f32x4 cv[2][2], bv[2][2];
#pragma unroll
        for (int bj = 0; bj < 2; ++bj)
#pragma unroll
            for (int n = 0; n < 2; ++n) { cv[bj][n] = *(const f32x4*)(cs + col0 + bj * HALF + 4 * n); bv[bj][n] = *(const f32x4*)(bw + col0 + bj * HALF + 4 * n); }
#pragma unroll
        for (int ai = 0; ai < 2; ++ai)
#pragma unroll
            for (int m = 0; m < 4; ++m) { const int row = row0 + ai * HALF + m * 16; bf16_t* rowp = O + (size_t)row * ldc + col0;
                const f32x2 st = *(const f32x2*)(ps + (size_t)row * 2); const float rs = st[1], nm = -st[0] * rs;
#pragma unroll
                for (int bj = 0; bj < 2; ++bj) { const f32x4 v0 = acc[ai][bj][m][0] * rs + (cv[bj][0] * nm + bv[bj][0]), v1 = acc[ai][bj][m][1] * rs + (cv[bj][1] * nm + bv[bj][1]);
                    u32x4 w; w.x = cvt_pk_bf16(v0[0], v0[1]); w.y = cvt_pk_bf16(v0[2], v0[3]); w.z = cvt_pk_bf16(v1[0], v1[1]); w.w = cvt_pk_bf16(v1[2], v1[3]);
                    *(u32x4*)(rowp + bj * HALF) = w; } }
    }
};
struct EpiBf16Sel {
    static constexpr bool PERM = true;
    bf16_t *O0, *O1, *O2, *O3;
    __device__ __forceinline__ void operator()(f32x4 (&acc)[2][2][4][2], const Unit& u, int wr, int wc, int fr, int fq) const {
        bf16_t* Ob = u.aux == 0 ? O0 : (u.aux == 1 ? O1 : (u.aux == 2 ? O2 : O3)); const int ld = (u.aux & 1) ? MEMT : DM;
        const int row0 = u.orow + wr * 64 + fr, col0 = u.ocol + wc * 32 + 8 * fq;
#pragma unroll
        for (int ai = 0; ai < 2; ++ai)
#pragma unroll
            for (int m = 0; m < 4; ++m) { bf16_t* rowp = Ob + (size_t)(row0 + ai * HALF + m * 16) * ld + col0;
#pragma unroll
                for (int bj = 0; bj < 2; ++bj) { const f32x4 v0 = acc[ai][bj][m][0], v1 = acc[ai][bj][m][1];
                    u32x4 w; w.x = cvt_pk_bf16(v0[0], v0[1]); w.y = cvt_pk_bf16(v0[2], v0[3]); w.z = cvt_pk_bf16(v1[0], v1[1]); w.w = cvt_pk_bf16(v1[2], v1[3]);
                    *(u32x4*)(rowp + bj * HALF) = w; } }
    }
};
struct EpiExp {
    static constexpr bool PERM = true;
    bf16_t* P; float* rsum; float sc;
    __device__ __forceinline__ void operator()(f32x4 (&acc)[2][2][4][2], const Unit& u, int wr, int wc, int fr, int fq) const {
        const int row0 = u.orow + wr * 64 + fr, col0 = u.ocol + wc * 32 + 8 * fq; const float k2 = sc * 1.4426950408889634f;
#pragma unroll
        for (int ai = 0; ai < 2; ++ai)
#pragma unroll
            for (int m = 0; m < 4; ++m) { const int row = row0 + ai * HALF + m * 16; bf16_t* rowp = P + (size_t)row * 1024 + col0; float s = 0.f;
#pragma unroll
                for (int bj = 0; bj < 2; ++bj) { f32x4 v0 = acc[ai][bj][m][0] * k2, v1 = acc[ai][bj][m][1] * k2;
#pragma unroll
                    for (int e = 0; e < 4; ++e) { v0[e] = __builtin_amdgcn_exp2f(v0[e]); v1[e] = __builtin_amdgcn_exp2f(v1[e]); }
                    s += (v0[0] + v0[1]) + (v0[2] + v0[3]) + (v1[0] + v1[1]) + (v1[2] + v1[3]);
                    u32x4 w; w.x = cvt_pk_bf16(v0[0], v0[1]); w.y = cvt_pk_bf16(v0[2], v0[3]); w.z = cvt_pk_bf16(v1[0], v1[1]); w.w = cvt_pk_bf16(v1[2], v1[3]);
                    *(u32x4*)(rowp + bj * HALF) = w; }
                s += sx(s, 16, fq * 16 + fr); s += sx(s, 32, fq * 16 + fr);
                if (fq == 0) rsum[((size_t)row * 4 + u.aux) * 4 + wc] = s; }
    }
};
struct EpiDivRow {
    static constexpr bool PERM = true;
    bf16_t* O; const float* rsum;
    __device__ __forceinline__ void operator()(f32x4 (&acc)[2][2][4][2], const Unit& u, int wr, int wc, int fr, int fq) const {
        const int row0 = u.orow + wr * 64 + fr, col0 = u.ocol + wc * 32 + 8 * fq;
#pragma unroll
        for (int ai = 0; ai < 2; ++ai)
#pragma unroll
            for (int m = 0; m < 4; ++m) { const int row = row0 + ai * HALF + m * 16; bf16_t* rowp = O + (size_t)row * DM + col0;
                const f32x4 ps = *(const f32x4*)(rsum + ((size_t)row * 4 + u.aux) * 4); const float inv = 1.0f / ((ps[0] + ps[1]) + (ps[2] + ps[3]));
#pragma unroll
                for (int bj = 0; bj < 2; ++bj) { const f32x4 v0 = acc[ai][bj][m][0] * inv, v1 = acc[ai][bj][m][1] * inv;
                    u32x4 w; w.x = cvt_pk_bf16(v0[0], v0[1]); w.y = cvt_pk_bf16(v0[2], v0[3]); w.z = cvt_pk_bf16(v1[0], v1[1]); w.w = cvt_pk_bf16(v1[2], v1[3]);
                    *(u32x4*)(rowp + bj * HALF) = w; } }
    }
};
template <int CTRL> __device__ __forceinline__ float dppf(float old, float src) { return __int_as_float(__builtin_amdgcn_update_dpp(__float_as_int(old), __float_as_int(src), CTRL, 0xf, 0xf, false)); }
struct EpiConvGate {
    static constexpr bool PERM = true;
    bf16_t* act; float* rawH; float* rawT; const float* cw; const float* cb; const float* ps; const float* cs; const float* bw;
    __device__ __forceinline__ void operator()(f32x4 (&acc)[2][2][4][2], const Unit& u, int wr, int wc, int fr, int fq) const {
        const int chb = (u.ocol >> 1) + wc * 32 + 8 * fq;
        {
            const int colq = u.ocol + wc * 32 + 8 * fq;
            float nmv[2][4], rsv[2][4];
#pragma unroll
            for (int ai = 0; ai < 2; ++ai)
#pragma unroll
                for (int m = 0; m < 4; ++m) { const f32x2 st = *(const f32x2*)(ps + (size_t)(u.orow + ai * HALF + wr * 64 + m * 16 + fr) * 2); rsv[ai][m] = st[1]; nmv[ai][m] = -st[0] * st[1]; }
#pragma unroll
            for (int bj = 0; bj < 2; ++bj)
#pragma unroll
                for (int n = 0; n < 2; ++n) { f32x4 cv = *(const f32x4*)(cs + colq + bj * HALF + 4 * n), bv = *(const f32x4*)(bw + colq + bj * HALF + 4 * n);
                    asm volatile("" : "+v"(cv), "+v"(bv));
#pragma unroll
                    for (int ai = 0; ai < 2; ++ai)
#pragma unroll
                        for (int m = 0; m < 4; ++m) acc[ai][bj][m][n] = acc[ai][bj][m][n] * rsv[ai][m] + (cv * nmv[ai][m] + bv); }
        }
#pragma unroll
        for (int ai = 0; ai < 2; ++ai) { const int run = (u.orow + ai * HALF + wr * 64) >> 6;
#pragma unroll
            for (int bj = 0; bj < 2; ++bj)
#pragma unroll
                for (int n = 0; n < 2; ++n) {
                    if (fr < 2) *(f32x4*)(rawH + ((size_t)(run * 2 + fr) * 2 + bj) * DFF + chb + 4 * n) = acc[ai][bj][0][n];
                    if (fr >= 14) *(f32x4*)(rawT + ((size_t)(run * 2 + fr - 14) * 2 + bj) * DFF + chb + 4 * n) = acc[ai][bj][3][n]; } }
        f32x4 w0, w1, w2, bb, nw0, nw1, nw2, nbb;
        { w0 = *(const f32x4*)(cw + chb); w1 = *(const f32x4*)(cw + NUP + chb); w2 = *(const f32x4*)(cw + 2 * NUP + chb); bb = *(const f32x4*)(cb + chb); nw0 = w0; nw1 = w1; nw2 = w2; nbb = bb; }
#pragma unroll
        for (int blk = 0; blk < 8; ++blk) {
            const int ai = blk >> 2, bj = (blk >> 1) & 1, n = blk & 1;
            if (blk < 7) { int chb_ = chb; asm volatile("" : "+v"(chb_));
                const int cidx = (((blk + 1) >> 1) & 1) * DFF + chb_ + 4 * ((blk + 1) & 1);
                nw0 = *(const f32x4*)(cw + cidx); nw1 = *(const f32x4*)(cw + NUP + cidx); nw2 = *(const f32x4*)(cw + 2 * NUP + cidx); nbb = *(const f32x4*)(cb + cidx); }
            asm volatile("" : "+v"(w0), "+v"(w1), "+v"(w2), "+v"(bb));
#pragma unroll
            for (int m = 3; m >= 0; --m) {
                f32x4 v = acc[ai][bj][m][n]; f32x4 pv = (m > 0) ? acc[ai][bj][m > 0 ? m - 1 : 0][n] : (f32x4){0.f, 0.f, 0.f, 0.f};
                asm volatile("" : "+v"(v), "+v"(pv));
                f32x4 r;
#pragma unroll
                for (int e = 0; e < 4; ++e) {
                    const float o1 = dppf<0x121>(0.f, pv[e]), o2 = dppf<0x122>(0.f, pv[e]);
                    const float p1 = dppf<0x111>(o1, v[e]), p2 = dppf<0x112>(o2, v[e]);
                    r[e] = w2[e] * v[e] + w1[e] * p1 + w0[e] * p2 + bb[e];
                }
                asm volatile("" : "+v"(r));
                acc[ai][bj][m][n] = r;
            }
            w0 = nw0; w1 = nw1; w2 = nw2; bb = nbb;
        }
#pragma unroll
        for (int ai = 0; ai < 2; ++ai)
#pragma unroll
            for (int m = 0; m < 4; ++m) { int row = u.orow + ai * HALF + wr * 64 + m * 16 + fr; asm volatile("" : "+v"(row)); f32x4 o[2];
#pragma unroll
                for (int n = 0; n < 2; ++n) { const f32x4 g = acc[ai][0][m][n], up = acc[ai][1][m][n];
#pragma unroll
                    for (int e = 0; e < 4; ++e) o[n][e] = g[e] * __builtin_amdgcn_rcpf(1.0f + __builtin_amdgcn_exp2f(-1.4426950408889634f * g[e])) * up[e]; }
                u32x4 w; w.x = cvt_pk_bf16(o[0][0], o[0][1]); w.y = cvt_pk_bf16(o[0][2], o[0][3]); w.z = cvt_pk_bf16(o[1][0], o[1][1]); w.w = cvt_pk_bf16(o[1][2], o[1][3]);
                *(u32x4*)(act + (size_t)row * DFF + chb) = w; }
    }
};

__device__ __forceinline__ void glds16s(const void* sbase_, unsigned voff, unsigned lds_dst) { unsigned keep;
    const unsigned long long pb_ = (unsigned long long)sbase_;
    const void* sbase = (const void*)(((unsigned long long)(unsigned)__builtin_amdgcn_readfirstlane((int)(pb_ >> 32)) << 32) | (unsigned)__builtin_amdgcn_readfirstlane((int)pb_));
    asm volatile("s_mov_b32 %0, m0\n\ts_mov_b32 m0, %3\n\ts_nop 0\n\tglobal_load_lds_dwordx4 %1, %2\n\ts_mov_b32 m0, %0" : "=&s"(keep) : "v"(voff), "s"(sbase), "s"(lds_dst) : "memory"); }
template <class Epi, class Sched>
__device__ __forceinline__ void gemm_phase(LAS unsigned char* lds, const Gemm g, const Sched& S, const Epi& E, int wave_id) {
    int lane_; asm volatile("v_mbcnt_lo_u32_b32 %0, -1, 0\n\tv_mbcnt_hi_u32_b32 %0, -1, %0" : "=v"(lane_));
    int wid_ = wave_id; asm volatile("" : "+s"(wid_));
    const int wid = wid_, lane = lane_, tid = wid * 64 + lane, wr = wid >> 2, wc = wid & 3, fr = lane & 15, fq = lane >> 4;
    const int nt = g.K / BK;
    unsigned voffA[2], voffB[2];
#pragma unroll
    for (int i = 0; i < 2; ++i) { int R, C; stage_rc(tid * 16 + i * 8192, R, C); const int Rb = Epi::PERM ? ((R & ~31) + perm32(R & 31)) : R;
        voffA[i] = (unsigned)(R * g.lda + C) * 2u; voffB[i] = (unsigned)(Rb * g.ldb + C) * 2u; }
    const size_t kstep = (size_t)(BK * 2);
    const size_t hA = (size_t)HALF * g.lda * 2, hB = (size_t)HALF * g.ldb * 2;
    const unsigned ldsw = (unsigned)wid * 1024u, ldsbase = (unsigned)(unsigned long)lds;
    const int aoff = lds_byte(wr * 64 + fr, fq * 8), boff = lds_byte(wc * 32 + fr, fq * 8);
#define PG8_SA(b, h) (((b) * 2 + (h)) * HTB)
#define PG8_SB(b, h) ((4 + (b) * 2 + (h)) * HTB)
#define PG8_STAGE(bufoff, gbase, voff) do { _Pragma("unroll") for (int _i = 0; _i < 2; ++_i) \
        glds16s((const void*)(gbase), (voff)[_i], (unsigned)__builtin_amdgcn_readfirstlane((int)(ldsbase + (unsigned)(bufoff) + ldsw + _i * 8192u))); } while (0)
#define PG8_LDA(dst, b, h) do { _Pragma("unroll") for (int m = 0; m < 4; ++m) _Pragma("unroll") for (int k = 0; k < 2; ++k) dst[m][k] = *(const LAS bf16x8*)(lds + PG8_SA(b, h) + aoff + m * 2048 + k * 1024); } while (0)
#define PG8_LDB(dst, b, h) do { _Pragma("unroll") for (int n = 0; n < 2; ++n) _Pragma("unroll") for (int k = 0; k < 2; ++k) dst[n][k] = *(const LAS bf16x8*)(lds + PG8_SB(b, h) + boff + n * 2048 + k * 1024); } while (0)
#define PG8_MMA(ai, bj, At, Bt) do { __builtin_amdgcn_s_setprio(1); _Pragma("unroll") for (int m = 0; m < 4; ++m) _Pragma("unroll") for (int n = 0; n < 2; ++n) _Pragma("unroll") for (int k = 0; k < 2; ++k) \
        acc[ai][bj][m][n] = __builtin_amdgcn_mfma_f32_16x16x32_bf16(Bt[n][k], At[m][k], acc[ai][bj][m][n], 0, 0, 0); __builtin_amdgcn_s_setprio(0); } while (0)
#define PG8_WAIT_V(n) asm volatile("s_waitcnt vmcnt(" #n ")" ::: "memory")
#define PG8_WAIT_L(n) asm volatile("s_waitcnt lgkmcnt(" #n ")" ::: "memory")
#define PG8_BAR __builtin_amdgcn_s_barrier()
#define PG8_SCHED __builtin_amdgcn_sched_barrier(0)
    Unit cur, nxt; int ui = 0;
    if (!S.next(0, cur)) return;
    f32x4 acc[2][2][4][2];
#pragma unroll
    for (int a = 0; a < 2; ++a)
#pragma unroll
        for (int b = 0; b < 2; ++b)
#pragma unroll
            for (int m = 0; m < 4; ++m)
#pragma unroll
                for (int n = 0; n < 2; ++n) acc[a][b][m][n] = (f32x4){0.f, 0.f, 0.f, 0.f};
    bf16x8 At[4][2], B0[2][2], B1[2][2];
    const char* cA = (const char*)g.A + cur.a_off; const char* cB = (const char*)g.Bt + cur.b_off;
    PG8_STAGE(PG8_SB(0, 0), cB, voffB); PG8_STAGE(PG8_SB(0, 1), cB + hB, voffB); PG8_STAGE(PG8_SA(0, 0), cA, voffA); PG8_STAGE(PG8_SA(0, 1), cA + hA, voffA);
    if (wr == 1) PG8_BAR;
    PG8_WAIT_V(2); PG8_BAR;
    PG8_STAGE(PG8_SB(1, 0), cB + kstep, voffB); PG8_STAGE(PG8_SA(1, 0), cA + kstep, voffA); PG8_STAGE(PG8_SB(1, 1), cB + hB + kstep, voffB);
    PG8_WAIT_V(6); PG8_BAR;
    for (;;) {
        const bool has_next = S.next(ui + 1, nxt);
        const char* nA = has_next ? (const char*)g.A + nxt.a_off : cA; const char* nB = has_next ? (const char*)g.Bt + nxt.b_off : cB;
        for (int t = 0; t < nt; t += 2) {
            const bool last = (t == nt - 2);
            const char* a1 = cA + (size_t)(t + 1) * kstep;
            const char* a2 = last ? nA : cA + (size_t)(t + 2) * kstep; const char* b2 = last ? nB : cB + (size_t)(t + 2) * kstep;
            const char* a3 = a2 + kstep; const char* b3 = b2 + kstep;
            PG8_LDB(B0, 0, 0); PG8_LDB(B1, 0, 1); PG8_SCHED; PG8_LDA(At, 0, 0); PG8_STAGE(PG8_SA(1, 1), a1 + hA, voffA);
            PG8_WAIT_V(8); PG8_WAIT_L(0); PG8_BAR; PG8_MMA(0, 0, At, B0); PG8_MMA(0, 1, At, B1); PG8_BAR; PG8_SCHED;
            PG8_LDA(At, 0, 1); PG8_STAGE(PG8_SB(0, 0), b2, voffB); PG8_STAGE(PG8_SB(0, 1), b2 + hB, voffB); PG8_STAGE(PG8_SA(0, 0), a2, voffA);
            PG8_WAIT_V(8); PG8_WAIT_L(0); PG8_BAR; PG8_MMA(1, 0, At, B0); PG8_MMA(1, 1, At, B1); PG8_BAR; PG8_SCHED;
            PG8_LDB(B0, 1, 0); PG8_LDB(B1, 1, 1); PG8_SCHED; PG8_LDA(At, 1, 0); PG8_STAGE(PG8_SA(0, 1), a2 + hA, voffA);
            PG8_WAIT_V(8); PG8_WAIT_L(0); PG8_BAR; PG8_MMA(0, 0, At, B0); PG8_MMA(0, 1, At, B1); PG8_BAR; PG8_SCHED;
            PG8_LDA(At, 1, 1); PG8_STAGE(PG8_SB(1, 0), b3, voffB); PG8_STAGE(PG8_SB(1, 1), b3 + hB, voffB); PG8_STAGE(PG8_SA(1, 0), a3, voffA);
            PG8_WAIT_V(8); PG8_WAIT_L(0); PG8_BAR; PG8_MMA(1, 0, At, B0); PG8_MMA(1, 1, At, B1); PG8_BAR; PG8_SCHED;
        }
        if (wr == 0) PG8_BAR;
        E(acc, cur, wr, wc, fr, fq);
        if (!has_next) break;
#pragma unroll
        for (int a = 0; a < 2; ++a)
#pragma unroll
            for (int b = 0; b < 2; ++b)
#pragma unroll
                for (int m = 0; m < 4; ++m)
#pragma unroll
                    for (int n = 0; n < 2; ++n) acc[a][b][m][n] = (f32x4){0.f, 0.f, 0.f, 0.f};
        cur = nxt; cA = nA; cB = nB; ++ui;
        if (wr == 1) PG8_BAR;
    }
    PG8_WAIT_V(0);
    PG8_BAR;
#undef PG8_SA
#undef PG8_SB
#undef PG8_STAGE
#undef PG8_LDA
#undef PG8_LDB
#undef PG8_MMA
#undef PG8_WAIT_V
#undef PG8_WAIT_L
#undef PG8_BAR
#undef PG8_SCHED
}
}

__device__ __forceinline__ unsigned f2bf(float f) { unsigned u = __builtin_bit_cast(unsigned, f); return (u + 0x7fffu + ((u >> 16) & 1u)) >> 16; }
__device__ __forceinline__ unsigned pk2(float lo, float hi) { return f2bf(lo) | (f2bf(hi) << 16); }
__device__ __forceinline__ float wave_sum(float v, int lane) {
#pragma unroll
    for (int o = 1; o < 64; o <<= 1) v += sx(v, o, lane);
    return v;
}
#define LDS_WAIT() asm volatile("s_waitcnt lgkmcnt(0)" ::: "memory")

struct Params {
    const float* in[23]; float* out; unsigned char* ws;
};

__device__ __forceinline__ void transpose_item(const float* W, int K, int N, bf16_t* WT, int mode, LAS float* scr, int item, int lane, const float* gvec, const float* bvec, float* csp, int nblk, int nmagic) {
    const int kb = (item * nmagic) >> 20, nb = item - kb * nblk, k0 = 64 * kb, n0 = 64 * nb;
    int r0 = n0;
    if (mode == 1) { const int bj = n0 / DFF, rem = n0 % DFF; r0 = 256 * (rem / 128) + 128 * bj + (rem % 128); }
    const int rr = lane >> 4, q = lane & 15;
    f32x4 t[16];
#pragma unroll
    for (int i = 0; i < 16; ++i) t[i] = *(const f32x4*)(W + (size_t)(k0 + 4 * i + rr) * N + n0 + 4 * q);
#pragma unroll
    for (int i = 0; i < 16; ++i) { LAS float* d = scr + (4 * i + rr) * 65 + 4 * q; d[0] = t[i][0]; d[1] = t[i][1]; d[2] = t[i][2]; d[3] = t[i][3]; }
    LDS_WAIT(); asm volatile("" ::: "memory");
    const int c = lane & 7;
    if (csp) {
        f32x4 g0 = (f32x4){1.f, 1.f, 1.f, 1.f}, g1 = g0, b0 = (f32x4){0.f, 0.f, 0.f, 0.f}, b1 = b0;
        if (gvec) { g0 = *(const f32x4*)(gvec + k0 + 8 * c); g1 = *(const f32x4*)(gvec + k0 + 8 * c + 4); b0 = *(const f32x4*)(bvec + k0 + 8 * c); b1 = *(const f32x4*)(bvec + k0 + 8 * c + 4); }
#pragma unroll
        for (int j = 0; j < 8; ++j) { const int n = (lane >> 3) + 8 * j; const LAS float* sp = scr + (8 * c) * 65 + n;
            const float w0 = sp[0 * 65], w1 = sp[1 * 65], w2 = sp[2 * 65], w3 = sp[3 * 65], w4 = sp[4 * 65], w5 = sp[5 * 65], w6 = sp[6 * 65], w7 = sp[7 * 65];
            u32x4 o; o.x = pk2(w0 * g0[0], w1 * g0[1]); o.y = pk2(w2 * g0[2], w3 * g0[3]); o.z = pk2(w4 * g1[0], w5 * g1[1]); o.w = pk2(w6 * g1[2], w7 * g1[3]);
            *(u32x4*)(WT + (size_t)(r0 + n) * K + k0 + 8 * c) = o;
            float cs = ((bflo(o.x) + bfhi(o.x)) + (bflo(o.y) + bfhi(o.y))) + ((bflo(o.z) + bfhi(o.z)) + (bflo(o.w) + bfhi(o.w)));
            float bs = ((w0 * b0[0] + w1 * b0[1]) + (w2 * b0[2] + w3 * b0[3])) + ((w4 * b1[0] + w5 * b1[1]) + (w6 * b1[2] + w7 * b1[3]));
            cs += sx(cs, 1, lane); bs += sx(bs, 1, lane); cs += sx(cs, 2, lane); bs += sx(bs, 2, lane); cs += sx(cs, 4, lane); bs += sx(bs, 4, lane);
            if (c == 0) { f32x2 o2; o2[0] = cs; o2[1] = bs; *(f32x2*)(csp + ((size_t)kb * NCOLS + r0 + n) * 2) = o2; } }
    } else {
#pragma unroll
        for (int j = 0; j < 8; ++j) { const int n = (lane >> 3) + 8 * j; const LAS float* sp = scr + (8 * c) * 65 + n;
            u32x4 o; o.x = pk2(sp[0 * 65], sp[1 * 65]); o.y = pk2(sp[2 * 65], sp[3 * 65]); o.z = pk2(sp[4 * 65], sp[5 * 65]); o.w = pk2(sp[6 * 65], sp[7 * 65]);
            *(u32x4*)(WT + (size_t)(r0 + n) * K + k0 + 8 * c) = o; }
    }
    LDS_WAIT(); asm volatile("" ::: "memory");
}

__device__ __forceinline__ void ln_row_bf(const float* xin, bf16_t* ybf, float* stat, const float* g, const float* b, int lane) {
    const f32x4* xr = (const f32x4*)xin + lane;
    f32x4 v[8]; float s = 0.f;
#pragma unroll
    for (int j = 0; j < 8; ++j) { v[j] = xr[64 * j]; s += (v[j][0] + v[j][1]) + (v[j][2] + v[j][3]); }
    const float mean = wave_sum(s, lane) * (1.f / DM); float s2 = 0.f;
#pragma unroll
    for (int j = 0; j < 8; ++j) { v[j] = v[j] - mean; s2 += (v[j][0] * v[j][0] + v[j][1] * v[j][1]) + (v[j][2] * v[j][2] + v[j][3] * v[j][3]); }
    const float rstd = 1.f / sqrtf(wave_sum(s2, lane) * (1.f / DM) + LN_EPS);
    if (lane == 0) { stat[0] = mean; stat[1] = rstd; }
    u32x2* o8 = (u32x2*)ybf + lane;
#pragma unroll
    for (int j = 0; j < 8; ++j) { const f32x4 gg = ((const f32x4*)g)[lane + 64 * j], bb = ((const f32x4*)b)[lane + 64 * j];
        const f32x4 y = v[j] * rstd * gg + bb; u32x2 w; w.x = pk2(y[0], y[1]); w.y = pk2(y[2], y[3]); o8[64 * j] = w; }
}
__device__ __forceinline__ void ln_row(const float* xin, float* yout, bf16_t* ybf, const float* g, const float* b, int lane) {
    const f32x4* xr = (const f32x4*)xin + lane;
    f32x4 v[8]; float s = 0.f;
#pragma unroll
    for (int j = 0; j < 8; ++j) { v[j] = xr[64 * j]; s += (v[j][0] + v[j][1]) + (v[j][2] + v[j][3]); }
    const float mean = wave_sum(s, lane) * (1.f / DM); float s2 = 0.f;
#pragma unroll
    for (int j = 0; j < 8; ++j) { v[j] = v[j] - mean; s2 += (v[j][0] * v[j][0] + v[j][1] * v[j][1]) + (v[j][2] * v[j][2] + v[j][3] * v[j][3]); }
    const float rstd = 1.f / sqrtf(wave_sum(s2, lane) * (1.f / DM) + LN_EPS);
    f32x4* yo = (f32x4*)yout + lane; u32x2* o8 = (u32x2*)ybf + lane;
#pragma unroll
    for (int j = 0; j < 8; ++j) { const f32x4 gg = ((const f32x4*)g)[lane + 64 * j], bb = ((const f32x4*)b)[lane + 64 * j];
        const f32x4 y = v[j] * rstd * gg + bb; yo[64 * j] = y; if (ybf) { u32x2 w; w.x = pk2(y[0], y[1]); w.y = pk2(y[2], y[3]); o8[64 * j] = w; } }
}

template <bool DO_DIFF, bool DO_DIL>
__device__ __forceinline__ void simple_attn_task(const bf16_t* proj, bf16_t* xo, int b, int h, int qb16, float lam, float lam_init, const float* g_diff, const float* g_dil, int lane, LAS float* resl) {
    const int ql = lane & 15, dvq = lane >> 4;
    const int t = qb16 * 16 + ql;
    const size_t rowb = (size_t)b * SEQ;
    const bf16_t* qrow = proj + (rowb + t) * NIN;
    if constexpr (DO_DIFF) {
        const float slope = exp2f(-(float)(2 * h + 1) * 0.5f);
#pragma unroll 1
        for (int c = 0; c < 2; ++c) {
            asm volatile("" ::: "memory");
            unsigned q[32];
            { const u32x4* qp = (const u32x4*)(qrow + h * 128 + c * 64);
#pragma unroll
              for (int i = 0; i < 8; ++i) { const u32x4 w = qp[i]; q[4 * i] = w[0]; q[4 * i + 1] = w[1]; q[4 * i + 2] = w[2]; q[4 * i + 3] = w[3]; } }
            float o[32];
#pragma unroll
            for (int d = 0; d < 32; ++d) o[d] = 0.f;
            float m = -1e30f, l = 0.f;
            const int kend = qb16 * 16 + 16;
#pragma unroll 1
            for (int k = 0; k < kend; ++k) {
                const bf16_t* krow = proj + (rowb + k) * NIN;
                const u32x4* kp = (const u32x4*)(krow + 1024 + h * 128 + c * 64);
                float s = 0.f;
#pragma unroll
                for (int i = 0; i < 8; ++i) { const u32x4 w = kp[i];
#pragma unroll
                    for (int e = 0; e < 4; ++e) { s += bflo(q[4 * i + e]) * bflo(w[e]); s += bfhi(q[4 * i + e]) * bfhi(w[e]); } }
                s = s * 0.125f - slope * (float)(t - k);
                asm volatile("" : "+v"(s) :: "memory");
                if (k <= t) {
                    if (s > m) { const float a = __expf(m - s); l *= a;
#pragma unroll
                        for (int d = 0; d < 32; ++d) o[d] *= a;
                        m = s; }
                    const float pr = __expf(s - m); l += pr;
                    const u32x4* vp = (const u32x4*)(krow + 2048 + h * 128 + dvq * 32);
#pragma unroll
                    for (int i = 0; i < 4; ++i) { const u32x4 w = vp[i];
#pragma unroll
                        for (int e = 0; e < 4; ++e) { o[8 * i + 2 * e] += pr * bflo(w[e]); o[8 * i + 2 * e + 1] += pr * bfhi(w[e]); } }
                }
            }
            const float inv = 1.f / l;
            if (c == 0) {
#pragma unroll
                for (int d = 0; d < 32; ++d) resl[d * 512] = o[d] * inv;
            } else {
                float ss = 0.f;
#pragma unroll
                for (int d = 0; d < 32; ++d) { if ((d & 7) == 0) asm volatile("" ::: "memory"); o[d] = resl[d * 512] - lam * o[d] * inv; ss += o[d] * o[d]; }
                ss += sx(ss, 16, lane); ss += sx(ss, 32, lane);
                const float r = (1.f / sqrtf(ss * (1.f / 128.f) + RMS_EPS)) * (1.f - lam_init);
                unsigned* op = (unsigned*)(xo + (rowb + t) * DM + h * 128 + dvq * 32);
#pragma unroll
                for (int d = 0; d < 32; d += 2) { if ((d & 7) == 0) asm volatile("" ::: "memory"); op[d >> 1] = pk2(o[d] * r * g_diff[dvq * 32 + d], o[d + 1] * r * g_diff[dvq * 32 + d + 1]); }
            }
        }
    }
    if constexpr (DO_DIL) {
        asm volatile("" ::: "memory");
        const float slope = exp2f(-(float)(h + 1));
        const float scale = 0.08838834764831845f;
        unsigned qpk[64];
        { const u32x4* qp = (const u32x4*)(qrow + 3072 + h * 128);
#pragma unroll
          for (int i = 0; i < 16; ++i) { const u32x4 w = qp[i]; qpk[4 * i] = w[0]; qpk[4 * i + 1] = w[1]; qpk[4 * i + 2] = w[2]; qpk[4 * i + 3] = w[3]; } }
        float o[32];
#pragma unroll
        for (int d = 0; d < 32; ++d) o[d] = 0.f;
        float m = -1e30f, l = 0.f;
#pragma unroll 1
        for (int br = 0; br < 3; ++br) {
            const int dil = br == 0 ? 1 : (br == 1 ? 4 : 16);
            const int p = t / dil;
#pragma unroll 1
            for (int j = 0; j <= 128; ++j) {
                if (j <= p) {
                    const int k = t - j * dil;
                    const bf16_t* krow = proj + (rowb + k) * NIN;
                    const u32x4* kp = (const u32x4*)(krow + 4096 + h * 128);
                    float s = 0.f;
#pragma unroll
                    for (int i = 0; i < 16; ++i) { const u32x4 w = kp[i];
#pragma unroll
                        for (int e = 0; e < 4; ++e) { s += bflo(qpk[4 * i + e]) * bflo(w[e]); s += bfhi(qpk[4 * i + e]) * bfhi(w[e]); } }
                    s = s * scale - slope * (float)(j * dil);
                    asm volatile("" : "+v"(s) :: "memory");
                    if (s > m) { const float a = __expf(m - s); l *= a;
#pragma unroll
                        for (int d = 0; d < 32; ++d) o[d] *= a;
                        m = s; }
                    const float pr = __expf(s - m); l += pr;
                    const u32x4* vp = (const u32x4*)(krow + 5120 + h * 128 + dvq * 32);
#pragma unroll
                    for (int i = 0; i < 4; ++i) { const u32x4 w = vp[i];
#pragma unroll
                        for (int e = 0; e < 4; ++e) { o[8 * i + 2 * e] += pr * bflo(w[e]); o[8 * i + 2 * e + 1] += pr * bfhi(w[e]); } }
                }
            }
        }
        const float inv = 1.f / l; float ss = 0.f;
#pragma unroll
        for (int d = 0; d < 32; ++d) { o[d] *= inv; ss += o[d] * o[d]; }
        ss += sx(ss, 16, lane); ss += sx(ss, 32, lane);
        const float r = 1.f / sqrtf(ss * (1.f / 128.f) + RMS_EPS);
        unsigned* op = (unsigned*)(xo + (rowb + t) * DM + 1024 + h * 128 + dvq * 32);
#pragma unroll
        for (int d = 0; d < 32; d += 2) { if ((d & 7) == 0) asm volatile("" ::: "memory"); op[d >> 1] = pk2(o[d] * r * g_dil[dvq * 32 + d], o[d + 1] * r * g_dil[dvq * 32 + d + 1]); }
    }
}


typedef float f32x16 __attribute__((ext_vector_type(16)));
typedef short s16x4 __attribute__((ext_vector_type(4)));
#define MFMA32(a, b, c) __builtin_amdgcn_mfma_f32_32x32x16_bf16((a), (b), (c), 0, 0, 0)
constexpr int VROWB = 320;
constexpr float LOG2E = 1.4426950408889634f, NEGBIG = -1e30f;
__device__ __forceinline__ s16x4 vtr(const LAS unsigned char* p) { return __builtin_bit_cast(s16x4, __builtin_amdgcn_ds_read_tr16_b64_v4i16((LAS s16x4*)p)); }
__device__ __forceinline__ int crow(int r, int hi) { return (r & 3) + 8 * (r >> 2) + 4 * hi; }
__device__ __forceinline__ void load_v(u32x4 (&t)[8], const bf16_t* vbase  , int rstride, unsigned voff  ) {
#pragma unroll
    for (int i = 0; i < 8; ++i) t[i] = *(const u32x4*)((const char*)(vbase + (size_t)(4 * i * rstride) * NIN) + voff);
}
__device__ __forceinline__ void store_v(LAS unsigned char* vl, const u32x4 (&t)[8], int lane) {
    const int rr = lane >> 4, ch = lane & 15;
#pragma unroll
    for (int i = 0; i < 8; ++i) *(LAS u32x4*)(vl + (4 * i + rr) * VROWB + ch * 16) = t[i];
}
constexpr int KROWB = 272;
constexpr int WAVE_LDS = 32 * VROWB + 32 * KROWB;
__device__ __forceinline__ void store_k(LAS unsigned char* kl, const u32x4 (&t)[8], int lane) {
    const int rr = lane >> 4, ch = lane & 15;
#pragma unroll
    for (int i = 0; i < 8; ++i) *(LAS u32x4*)(kl + (4 * i + rr) * KROWB + ch * 16) = t[i];
}
__device__ __forceinline__ void read_kf(bf16x8 (&kf)[8], const LAS unsigned char* klane  ) {
#pragma unroll
    for (int d0 = 0; d0 < 8; ++d0) kf[d0] = *(const LAS bf16x8*)(klane + 32 * d0);
}
__device__ __forceinline__ void pv_chunk(f32x16 (&ot)[4], const LAS unsigned char* vtb, bf16x8 pf0, bf16x8 pf1) {
#pragma unroll
    for (int db = 0; db < 4; ++db)
#pragma unroll
        for (int s = 0; s < 2; ++s) {
            const s16x4 a = vtr(vtb + (16 * s) * VROWB + 64 * db), b2 = vtr(vtb + (16 * s + 8) * VROWB + 64 * db);
            const bf16x8 vf = (bf16x8){a[0], a[1], a[2], a[3], b2[0], b2[1], b2[2], b2[3]};
            __builtin_amdgcn_s_setprio(1); ot[db] = MFMA32(vf, s ? pf1 : pf0, ot[db]); __builtin_amdgcn_s_setprio(0);
        }
}
__device__ __forceinline__ bf16x8 pack8(const float* p) {
    u32x4 w; w.x = pg8::cvt_pk_bf16(p[0], p[1]); w.y = pg8::cvt_pk_bf16(p[2], p[3]); w.z = pg8::cvt_pk_bf16(p[4], p[5]); w.w = pg8::cvt_pk_bf16(p[6], p[7]);
    return __builtin_bit_cast(bf16x8, w);
}
__device__ __forceinline__ void store_rows_wide(bf16_t* op  , u32x2 (&o2)[16], int hi) {
#pragma unroll
    for (int k = 0; k < 16; k += 2) { u32x2 a = o2[k], b = o2[k + 1];
        { auto r = __builtin_amdgcn_permlane32_swap(a.x, b.x, false, false); a.x = r[0]; b.x = r[1]; }
        { auto r = __builtin_amdgcn_permlane32_swap(a.y, b.y, false, false); a.y = r[0]; b.y = r[1]; }
        u32x4 w; w.x = a.x; w.y = a.y; w.z = b.x; w.w = b.y;
        *(u32x4*)(op + 8 * k + 8 * hi) = w; }
}
__device__ __forceinline__ void diff_task(const bf16_t* proj, bf16_t* xo, int b, int h, int qb, float lam, float post, const float* g_diff, int  , LAS unsigned char* vl) {
    int lane; asm volatile("v_mbcnt_lo_u32_b32 %0, -1, 0\n\tv_mbcnt_hi_u32_b32 %0, -1, %0" : "=v"(lane));
    const int r32 = lane & 31, hi = lane >> 5;
    const size_t rowb = (size_t)b * SEQ;
    const int qpos = qb * 32 + r32;
    const float slope = exp2f(-(float)(2 * h + 1) * 0.5f);
    const float c1 = 0.125f * LOG2E, c2 = slope * LOG2E, c2s = c2 * 32.f;
    bf16x8 qf[8];
    { const bf16_t* qp = proj + (rowb + qpos) * NIN + h * 128 + 8 * hi;
#pragma unroll
      for (int d0 = 0; d0 < 8; ++d0) qf[d0] = *(const bf16x8*)(qp + 16 * d0); }
    const bf16_t* kcol = proj + 1024 + h * 128 + rowb * NIN;
    const bf16_t* vcol = proj + 2048 + h * 128 + rowb * NIN;
    const unsigned voff = (unsigned)((lane >> 4) * NIN + (lane & 15) * 8) * 2u;
    LAS unsigned char* kl = vl + 32 * VROWB;
    const LAS unsigned char* klane = kl + r32 * KROWB + 16 * hi;
    const float bb = -c2 * (float)(qpos - 4 * hi);
#define B0(r) (bb + c2 * (float)(((r) & 3) + 8 * ((r) >> 2)))
    float m0 = NEGBIG, l0 = 0.f, m1 = NEGBIG, l1 = 0.f;
    bf16x8 kf[8]; u32x4 kr[8];
    float sh = 0.f;
    {
        u32x4 krb[8];
        const LAS unsigned char* klaneB = vl + r32 * VROWB + 16 * hi;
        load_v(kr, kcol, 1, voff);
        load_v(krb, kcol + (size_t)((qb >= 1 ? 1 : 0) * 32) * NIN, 1, voff);
        store_k(kl, kr, lane); store_v(vl, krb, lane);
#define DIFF_STATS(S0, S1, KC) do { \
            _Pragma("unroll") for (int r = 0; r < 16; ++r) { const float bq = B0(r); S0[r] = S0[r] * c1 + bq; S1[r] = S1[r] * c1 + bq; } \
            if ((KC) == qb) { _Pragma("unroll") for (int r = 0; r < 16; ++r) if (crow(r, hi) > r32) { S0[r] = NEGBIG; S1[r] = NEGBIG; } } \
            float cm0 = S0[0], cm1 = S1[0]; \
            _Pragma("unroll") for (int r = 1; r < 16; ++r) { cm0 = fmaxf(cm0, S0[r]); cm1 = fmaxf(cm1, S1[r]); } \
            const float shk = c2s * (float)(KC); \
            const float n0 = fmaxf(m0, cm0 + shk), n1 = fmaxf(m1, cm1 + shk), e0 = n0 - shk, e1 = n1 - shk; \
            float a0 = 0.f, a1 = 0.f; \
            _Pragma("unroll") for (int r = 0; r < 16; ++r) { a0 += __builtin_amdgcn_exp2f(S0[r] - e0); a1 += __builtin_amdgcn_exp2f(S1[r] - e1); } \
            l0 = l0 * __builtin_amdgcn_exp2f(m0 - n0) + a0; l1 = l1 * __builtin_amdgcn_exp2f(m1 - n1) + a1; m0 = n0; m1 = n1; } while (0)
#pragma unroll 1
        for (int kc = 0; kc <= qb; kc += 2) {
            f32x16 sa0 = {}, sa1 = {}, sb0 = {}, sb1 = {};
            read_kf(kf, klane);
#pragma unroll
            for (int d0 = 0; d0 < 4; ++d0) { sa0 = MFMA32(kf[d0], qf[d0], sa0); sa1 = MFMA32(kf[4 + d0], qf[4 + d0], sa1); }
            read_kf(kf, klaneB);
#pragma unroll
            for (int d0 = 0; d0 < 4; ++d0) { sb0 = MFMA32(kf[d0], qf[d0], sb0); sb1 = MFMA32(kf[4 + d0], qf[4 + d0], sb1); }
            const int ka = kc + 2 <= qb ? kc + 2 : qb, kb2 = kc + 3 <= qb ? kc + 3 : qb;
            load_v(kr, kcol + (size_t)(ka * 32) * NIN, 1, voff);
            DIFF_STATS(sa0, sa1, kc);
            asm volatile("" : "+v"(m0), "+v"(l0), "+v"(m1), "+v"(l1));
            load_v(krb, kcol + (size_t)(kb2 * 32) * NIN, 1, voff);
            if (kc + 1 <= qb) DIFF_STATS(sb0, sb1, kc + 1);
            store_k(kl, kr, lane); store_v(vl, krb, lane);
        }
#undef DIFF_STATS
    }
    { const float mo0 = sx(m0, 32, lane), lo0 = sx(l0, 32, lane), mo1 = sx(m1, 32, lane), lo1 = sx(l1, 32, lane);
      const float M0 = fmaxf(m0, mo0), M1 = fmaxf(m1, mo1);
      l0 = l0 * __builtin_amdgcn_exp2f(m0 - M0) + lo0 * __builtin_amdgcn_exp2f(mo0 - M0); l1 = l1 * __builtin_amdgcn_exp2f(m1 - M1) + lo1 * __builtin_amdgcn_exp2f(mo1 - M1); m0 = M0; m1 = M1; }
    const float i0 = 1.0f / l0, i1 = lam / l1;
    f32x16 ot[4];
#pragma unroll
    for (int db = 0; db < 4; ++db) ot[db] = (f32x16){};
    const int g = lane >> 4, ii = lane & 15;
    const LAS unsigned char* vtb = vl + (4 * (g >> 1) + (ii >> 2)) * VROWB + (16 * (g & 1) + 4 * (ii & 3)) * 2;
    u32x4 vr[8];
    load_v(vr, vcol, 1, voff);
    load_v(kr, kcol, 1, voff);
    store_v(vl, vr, lane);
    store_k(kl, kr, lane);
    sh = 0.f;
#pragma unroll 1
    for (int kc = 0; kc <= qb; ++kc) {
        read_kf(kf, klane);
        f32x16 s0 = {}, s1 = {};
#pragma unroll
        for (int d0 = 0; d0 < 4; ++d0) { s0 = MFMA32(kf[d0], qf[d0], s0); s1 = MFMA32(kf[4 + d0], qf[4 + d0], s1); }
        const int kn = kc < qb ? kc + 1 : kc;
        load_v(kr, kcol + (size_t)(kn * 32) * NIN, 1, voff);
        if (kc == qb) {
#pragma unroll
            for (int r = 0; r < 16; ++r) if (crow(r, hi) > r32) { s0[r] = NEGBIG; s1[r] = NEGBIG; }
        }
        const float e0 = m0 - sh, e1 = m1 - sh;
        float p[16];
#pragma unroll
        for (int r = 0; r < 16; ++r) { const float bq0 = B0(r) - e0, bq1 = B0(r) - e1; p[r] = __builtin_amdgcn_exp2f(s0[r] * c1 + bq0) * i0 - __builtin_amdgcn_exp2f(s1[r] * c1 + bq1) * i1; }
        bf16x8 pf0 = pack8(p), pf1 = pack8(p + 8);
        asm volatile("" : "+v"(pf0), "+v"(pf1));
        load_v(vr, vcol + (size_t)(kn * 32) * NIN, 1, voff);
        pv_chunk(ot, vtb, pf0, pf1);
        store_k(kl, kr, lane);
        store_v(vl, vr, lane);
        sh += c2s;
    }
    float ss = 0.f;
#pragma unroll
    for (int db = 0; db < 4; ++db)
#pragma unroll
        for (int r = 0; r < 16; ++r) ss += ot[db][r] * ot[db][r];
    ss += sx(ss, 32, lane);
    const float rn = (1.0f / sqrtf(ss * (1.f / 128.f) + RMS_EPS)) * post;
    bf16_t* op = xo + (rowb + qpos) * DM + h * 128;
    u32x2 o2[16];
#pragma unroll
    for (int db = 0; db < 4; ++db)
#pragma unroll
        for (int rg = 0; rg < 4; ++rg) { const int d = 32 * db + 8 * rg + 4 * hi; const f32x4 gg = *(const f32x4*)(g_diff + d);
            u32x2 w; w.x = pg8::cvt_pk_bf16(ot[db][4 * rg] * rn * gg[0], ot[db][4 * rg + 1] * rn * gg[1]); w.y = pg8::cvt_pk_bf16(ot[db][4 * rg + 2] * rn * gg[2], ot[db][4 * rg + 3] * rn * gg[3]);
            o2[4 * db + rg] = w; }
    store_rows_wide(op, o2, hi);
}
struct PendingOut { u32x2 o2[16]; bf16_t* op; float* lsep; float lsev; int valid; };
__device__ __forceinline__ void flush_pending(PendingOut& pd, int hi) {
    if (pd.valid) { store_rows_wide(pd.op, pd.o2, hi); if (hi == 0) *pd.lsep = pd.lsev; pd.valid = 0; }
}
__device__ __forceinline__ void dil_task(const bf16_t* proj, bf16_t* po, int ldo, float* lse, int b, int h, int dil, int c, int pb, int  , LAS unsigned char* vl, PendingOut& pd) {
    int lane; asm volatile("v_mbcnt_lo_u32_b32 %0, -1, 0\n\tv_mbcnt_hi_u32_b32 %0, -1, %0" : "=v"(lane));
    const int r32 = lane & 31, hi = lane >> 5;
    const size_t row0 = (size_t)b * SEQ + c;
    const size_t qrow = row0 + (size_t)(pb * 32 + r32) * dil;
    const float slope = exp2f(-(float)(h + 1));
    const float c1 = 0.08838834764831845f * LOG2E, c2 = slope * LOG2E * (float)dil, c2s = c2 * 32.f;
    bf16x8 qf[8];
    { const bf16_t* qp = proj + qrow * NIN + 3072 + h * 128 + 8 * hi;
#pragma unroll
      for (int d0 = 0; d0 < 8; ++d0) qf[d0] = *(const bf16x8*)(qp + 16 * d0); }
    const bf16_t* kcol = proj + 4096 + h * 128 + row0 * NIN;
    const bf16_t* vcol = proj + 5120 + h * 128 + row0 * NIN;
    const unsigned voff = (unsigned)((lane >> 4) * dil * NIN + (lane & 15) * 8) * 2u;
    const size_t cstep = (size_t)32 * dil;
    const int g = lane >> 4, ii = lane & 15;
    const LAS unsigned char* vtb = vl + (4 * (g >> 1) + (ii >> 2)) * VROWB + (16 * (g & 1) + 4 * (ii & 3)) * 2;
    LAS unsigned char* kl = vl + 32 * VROWB;
    const LAS unsigned char* klane = kl + r32 * KROWB + 16 * hi;
    const float bb = -c2 * (float)(r32 - 4 * hi);
    f32x16 ot[4];
#pragma unroll
    for (int db = 0; db < 4; ++db) ot[db] = (f32x16){};
    float m = NEGBIG, l = 0.f;
    const int kc0 = pb >= 4 ? pb - 4 : 0;
    bf16x8 kf[8]; u32x4 vr[8], kr[8];
    load_v(vr, vcol + kc0 * cstep * NIN, dil, voff);
    load_v(kr, kcol + kc0 * cstep * NIN, dil, voff);
    flush_pending(pd, hi);
    store_v(vl, vr, lane);
    store_k(kl, kr, lane);
    float sh = -c2s * (float)(pb - kc0);
#pragma unroll 1
    for (int kc = kc0; kc <= pb; ++kc) {
        read_kf(kf, klane);
        f32x16 st = {};
#pragma unroll
        for (int d0 = 0; d0 < 8; ++d0) st = MFMA32(kf[d0], qf[d0], st);
        const int kn = kc < pb ? kc + 1 : kc;
        load_v(kr, kcol + kn * cstep * NIN, dil, voff);
#pragma unroll
        for (int r = 0; r < 16; ++r) st[r] = st[r] * c1 + B0(r);
        if (kc == pb) {
#pragma unroll
            for (int r = 0; r < 16; ++r) if (crow(r, hi) > r32) st[r] = NEGBIG;
        }
        if (kc + 4 == pb) {
#pragma unroll
            for (int r = 0; r < 16; ++r) if (crow(r, hi) < r32) st[r] = NEGBIG;
        }
        float cm = st[0];
#pragma unroll
        for (int r = 1; r < 16; ++r) cm = fmaxf(cm, st[r]);
        cm = fmaxf(cm, sx(cm, 32, lane)) + sh;
        const float mn = fmaxf(m, cm), al = __builtin_amdgcn_exp2f(m - mn), e = mn - sh;
        m = mn; l *= al;
#pragma unroll
        for (int db = 0; db < 4; ++db) ot[db] = ot[db] * al;
        float p[16]; float a = 0.f;
#pragma unroll
        for (int r = 0; r < 16; ++r) { p[r] = __builtin_amdgcn_exp2f(st[r] - e); a += p[r]; }
        l += a;
        bf16x8 pf0 = pack8(p), pf1 = pack8(p + 8);
        asm volatile("" : "+v"(pf0), "+v"(pf1));
        load_v(vr, vcol + kn * cstep * NIN, dil, voff);
        pv_chunk(ot, vtb, pf0, pf1);
        store_k(kl, kr, lane);
        store_v(vl, vr, lane);
        sh += c2s;
    }
    l += sx(l, 32, lane);
    const float inv = 1.0f / l;
#pragma unroll
    for (int db = 0; db < 4; ++db)
#pragma unroll
        for (int rg = 0; rg < 4; ++rg) { u32x2 w; w.x = pg8::cvt_pk_bf16(ot[db][4 * rg] * inv, ot[db][4 * rg + 1] * inv); w.y = pg8::cvt_pk_bf16(ot[db][4 * rg + 2] * inv, ot[db][4 * rg + 3] * inv); pd.o2[4 * db + rg] = w; }
    pd.op = po + qrow * ldo + h * 128; pd.lsep = lse + qrow * 8 + h; pd.lsev = m + __builtin_amdgcn_logf(l); pd.valid = 1;
}
__device__ __forceinline__ void dil_combine_load(float (&o)[16], float& rn, const bf16_t* p0, const bf16_t* p1, const bf16_t* xo, const float* lse0, const float* lse1, const float* lse2, int lane) {
    const int h = lane >> 3, seg = lane & 7;
    const float e0 = lse0[h], e1 = lse1[h], e2 = lse2[h], em = fmaxf(e0, fmaxf(e1, e2));
    float w0 = __builtin_amdgcn_exp2f(e0 - em), w1 = __builtin_amdgcn_exp2f(e1 - em), w2 = __builtin_amdgcn_exp2f(e2 - em); const float wi = 1.0f / (w0 + w1 + w2); w0 *= wi; w1 *= wi; w2 *= wi;
    const int off = h * 128 + seg * 16;
    float ss = 0.f;
#pragma unroll
    for (int j = 0; j < 2; ++j) { const u32x4 a = *(const u32x4*)(p0 + off + 8 * j), bq = *(const u32x4*)(p1 + off + 8 * j), cq = *(const u32x4*)(xo + off + 8 * j);
#pragma unroll
        for (int e = 0; e < 4; ++e) { o[8 * j + 2 * e] = w0 * bflo(a[e]) + w1 * bflo(bq[e]) + w2 * bflo(cq[e]); o[8 * j + 2 * e + 1] = w0 * bfhi(a[e]) + w1 * bfhi(bq[e]) + w2 * bfhi(cq[e]); } }
#pragma unroll
    for (int d = 0; d < 16; ++d) ss += o[d] * o[d];
    ss += sx(ss, 1, lane); ss += sx(ss, 2, lane); ss += sx(ss, 4, lane);
    rn = 1.0f / sqrtf(ss * (1.f / 128.f) + RMS_EPS);
}
__device__ __forceinline__ void dil_combine_store(const float (&o)[16], float rn, bf16_t* xo, const float* g_dil, int lane) {
    const int h = lane >> 3, seg = lane & 7; const int off = h * 128 + seg * 16;
#pragma unroll
    for (int j = 0; j < 2; ++j) { u32x4 w;
#pragma unroll
        for (int e = 0; e < 4; ++e) w[e] = pk2(o[8 * j + 2 * e] * rn * g_dil[seg * 16 + 8 * j + 2 * e], o[8 * j + 2 * e + 1] * rn * g_dil[seg * 16 + 8 * j + 2 * e + 1]);
        *(u32x4*)(xo + off + 8 * j) = w; }
}

#define XB_TMO      128
#define XB_XCNT(j)  (256  + 64 * (j))
#define XB_XSUB(j)  (1280 + 64 * (j))
#define XB_XGEN(j)  (2304 + 64 * (j))
#define XB_TOP      3328
#define XB_TOPGEN   3392
#define XCD_BAR_WORDS 3456
#define XB_SPIN_CAP (1u << 22)

__device__ __forceinline__ unsigned xb_ld(unsigned* p)              { return __hip_atomic_load(p, __ATOMIC_RELAXED, __HIP_MEMORY_SCOPE_AGENT); }
__device__ __forceinline__ unsigned xb_add(unsigned* p, unsigned v) { return __hip_atomic_fetch_add(p, v, __ATOMIC_RELAXED, __HIP_MEMORY_SCOPE_AGENT); }
__device__ __forceinline__ unsigned xb_xcc_id() { return (unsigned)__builtin_amdgcn_s_getreg((3 << 11) | 20) & 0xFu; }
#define XB_SPIN(cond, bar) do { unsigned _sp = 0; while (cond) { __builtin_amdgcn_s_sleep(1); \
    if ((++_sp & 255u) == 0u) { if (xb_ld(&(bar)[XB_TMO])) break; if (_sp > XB_SPIN_CAP) { atomicAdd(&(bar)[XB_TMO], 1u); break; } } } } while (0)

struct XcdBarrier {
    unsigned* bar; unsigned x;
    volatile LAS unsigned* st;
};

__device__ __forceinline__ XcdBarrier xcd_barrier_post(unsigned* bar, volatile LAS unsigned* st) {
    XcdBarrier b; b.bar = bar; b.x = xb_xcc_id(); b.st = st;
    if (threadIdx.x == 0) (void)xb_add(&bar[XB_XCNT(b.x)], 1u);
    return b;
}
__device__ __forceinline__ void xcd_barrier_complete(unsigned* bar, unsigned x, unsigned& nloc, unsigned& nx) {
    const unsigned G = gridDim.x * gridDim.y * gridDim.z;
    unsigned sum, cnt, mine, sp = 0u;
    for (;;) {
        sum = 0u; cnt = 0u; mine = 0u;
#pragma unroll
        for (unsigned j = 0; j < 16; ++j) { const unsigned c = xb_ld(&bar[XB_XCNT(j)]); sum += c; cnt += (c > 0u) ? 1u : 0u; mine = (j == x) ? c : mine; }
        if (sum == G) break;
        __builtin_amdgcn_s_sleep(1);
        if ((++sp & 255u) == 0u) { if (xb_ld(&bar[XB_TMO])) break; if (sp > XB_SPIN_CAP) { atomicAdd(&bar[XB_TMO], 1u); break; } }
    }
    nloc = mine > 0u ? mine : 1u; nx = cnt > 0u ? cnt : 1u;
}

__device__ __forceinline__ void xcd_barrier(const XcdBarrier& b) {
    asm volatile("s_waitcnt vmcnt(0)" ::: "memory");
    __syncthreads();
    if (threadIdx.x == 0) {
        unsigned* bar = b.bar;
        __builtin_amdgcn_s_waitcnt(0);
        unsigned nloc = b.st[0], nx = b.st[1];
        if (nloc == 0u) { xcd_barrier_complete(bar, b.x, nloc, nx); b.st[0] = nloc; b.st[1] = nx; }
        const unsigned old = xb_add(&bar[XB_XSUB(b.x)], 1u);
        const unsigned gen = old / nloc;
        if (old + 1u == (gen + 1u) * nloc) {
            __builtin_amdgcn_fence(__ATOMIC_RELEASE, "agent");
            asm volatile("s_waitcnt vmcnt(0)" ::: "memory");
            const unsigned og = xb_add(&bar[XB_TOP], 1u);
            const unsigned tg = og / nx;
            if (og + 1u == (tg + 1u) * nx) xb_add(&bar[XB_TOPGEN], 1u);
            else XB_SPIN(xb_ld(&bar[XB_TOPGEN]) == tg, bar);
            __builtin_amdgcn_fence(__ATOMIC_ACQUIRE, "agent");
            xb_add(&bar[XB_XGEN(b.x)], 1u);
            asm volatile("s_waitcnt vmcnt(0)" ::: "memory");
        } else {
            XB_SPIN(xb_ld(&bar[XB_XGEN(b.x)]) == gen, bar);
            __builtin_amdgcn_fence(__ATOMIC_ACQUIRE, "agent");
            asm volatile("s_waitcnt vmcnt(0)" ::: "memory");
        }
    }
    __syncthreads();
}

constexpr int NWAVES = 8;
constexpr int GRID_BLOCKS = 256;
constexpr int LDS_BYTES = 155648;

__global__ void __launch_bounds__(NWAVES * 64, 2) mega_fwd(Params P) {
    extern __shared__ __attribute__((aligned(16))) unsigned char lds_raw[];
    LAS unsigned char* lds = (LAS unsigned char*)lds_raw;
    cg::grid_group grid = cg::this_grid();
    const int wave = __builtin_amdgcn_readfirstlane((int)threadIdx.x >> 6);
    constexpr int G = GRID_BLOCKS; const int bx = blockIdx.x;
    const int gw = bx * NWAVES + wave, NGW = G * NWAVES;
    const int NGT = G * NWAVES * 64;
#define PH_IDS int lane_; asm volatile("v_mbcnt_lo_u32_b32 %0, -1, 0\n\tv_mbcnt_hi_u32_b32 %0, -1, %0" : "=v"(lane_)); const int lane = lane_; const int tid_ = wave * 64 + lane_; const int gt = bx * (NWAVES * 64) + tid_; (void)lane; (void)gt; (void)tid_;
    unsigned char* ws = P.ws;
    const float* x = P.in[0]; const float* mem = P.in[1];
    bf16_t* Wl = (bf16_t*)(ws + WS_W);
    bf16_t* XB = (bf16_t*)(ws + WS_XB); bf16_t* XBB = (bf16_t*)(ws + WS_XBB);
    bf16_t* BIG = (bf16_t*)(ws + WS_BIG);
    bf16_t* MEMB = (bf16_t*)(ws + WS_MEMB); bf16_t* KMEM = (bf16_t*)(ws + WS_KMEM); bf16_t* VT = (bf16_t*)(ws + WS_VT);
    float* RAWH = (float*)(ws + WS_RAWH); float* RAWT = (float*)(ws + WS_RAWT); float* RSUM = (float*)(ws + WS_RSUM);
    float* H = P.out;
    volatile LAS unsigned* bar_st = (volatile LAS unsigned*)(lds + LDS_BYTES - 64);
    if (threadIdx.x < 2) bar_st[threadIdx.x] = 0u;
    __syncthreads();
    XcdBarrier xbar = xcd_barrier_post((unsigned*)ws, bar_st);
#define GRID_SYNC() xcd_barrier(xbar)
    float* IDENT = (float*)(ws + WS_IDENT); float* STATS = (float*)(ws + WS_STATS);
    float* CSF = (float*)(ws + WS_CSF); float* BWF = CSF + NCOLS;
    float* CSP = (float*)(ws + WS_BIG + 64 * MiB);
    bf16_t* WKV = BIG;
    bf16_t* PART0 = (bf16_t*)(ws + WS_RAWH); bf16_t* PART1 = (bf16_t*)(ws + WS_PART1); float* LSE = (float*)(ws + WS_LSE);
#define PSTAT(i) ((float*)(ws + WS_PSTAT + (size_t)(i) * 8 * MiB))

#pragma unroll 1
    for (int l = 0; l < NLAYER; ++l) {
        {
            PH_IDS
            LAS float* scr = (LAS float*)(lds + wave * 17408);
            if (l == 0) {
                for (int i = gt; i < 2 * DM; i += NGT) IDENT[i] = i < DM ? 1.f : 0.f;
                for (size_t i = gt; i < (size_t)TOK * DM / 4; i += (size_t)NGT * 8) { f32x4 v[8];
#pragma unroll
                    for (int j = 0; j < 8; ++j) v[j] = ((const f32x4*)x)[i + (size_t)j * NGT];
#pragma unroll
                    for (int j = 0; j < 8; ++j) { u32x2 w; w.x = pk2(v[j][0], v[j][1]); w.y = pk2(v[j][2], v[j][3]); ((u32x2*)XBB)[i + (size_t)j * NGT] = w; } }
                for (size_t i = gt; i < (size_t)MEMT * DM / 4; i += (size_t)NGT * 8) { f32x4 v[8];
#pragma unroll
                    for (int j = 0; j < 8; ++j) v[j] = ((const f32x4*)mem)[i + (size_t)j * NGT];
#pragma unroll
                    for (int j = 0; j < 8; ++j) { u32x2 w; w.x = pk2(v[j][0], v[j][1]); w.y = pk2(v[j][2], v[j][3]); ((u32x2*)MEMB)[i + (size_t)j * NGT] = w; } }
                for (int i = gt; i < 2 * TOK; i += NGT) STATS[i] = (float)(i & 1);
            }
#pragma unroll 1
            for (int k = 0; k < 8; ++k) {
                if (k >= 6 && l != 0) break;
                const float* src; int K, N, mode = 0; bf16_t* dst; const float* gv = nullptr; const float* bv = nullptr; float* csp = nullptr;
                if (k == 0)      { src = P.in[2]  + (size_t)l * DM * NIN;  K = DM;  N = NIN; dst = Wl + WO_IN;  csp = CSP + (size_t)CB_IN * 2; }
                else if (k == 1) { src = P.in[3]  + (size_t)l * DM * DM;   K = DM;  N = DM;  dst = Wl + WO_OUT; }
                else if (k == 2) { src = P.in[12] + (size_t)l * DM * DM;   K = DM;  N = DM;  dst = Wl + WO_Q;   gv = P.in[10] + l * DM; bv = P.in[11] + l * DM; csp = CSP + (size_t)CB_Q * 2; }
                else if (k == 3) { src = P.in[14] + (size_t)l * DM * DM;   K = DM;  N = DM;  dst = Wl + WO_O; }
                else if (k == 4) { src = P.in[17] + (size_t)l * DM * NUP;  K = DM;  N = NUP; dst = Wl + WO_UP;  mode = 1; gv = P.in[15] + l * DM; bv = P.in[16] + l * DM; csp = CSP + (size_t)CB_UP * 2; }
                else if (k == 5) { src = P.in[20] + (size_t)l * DFF * DM;  K = DFF; N = DM;  dst = Wl + WO_DN; }
                else             { src = P.in[13] + (size_t)(k - 6) * DM * 2 * DM; K = DM; N = 2 * DM; dst = WKV + (size_t)(k - 6) * 2 * DM * DM; }
                if (k == 0 && l != 0) { gv = P.in[21] + (l - 1) * DM; bv = P.in[22] + (l - 1) * DM; }
                const int nblk = N >> 6, nmagic = N == NIN ? 10923 : (N == DM ? 32768 : (N == NUP ? 5958 : 16384));
                const int items = (K >> 6) * nblk;
                for (int it = gw; it < items; it += NGW) transpose_item(src, K, N, dst, mode, scr, it, lane, gv, bv, csp, nblk, nmagic);
            }
        }
        __syncthreads();
        if (l == 0) grid.sync(); else GRID_SYNC();
        {
            PH_IDS
            for (int col = gt; col < NCOLS; col += NGT) { float cs = 0.f, bs = 0.f;
#pragma unroll 8
                for (int kb = 0; kb < 32; ++kb) { const f32x2 v = *(const f32x2*)(CSP + ((size_t)kb * NCOLS + col) * 2); cs += v[0]; bs += v[1]; }
                CSF[col] = cs; BWF[col] = bs; }
        }
        if (l == 0) {
            pg8::Gemm g{(const bf16_t*)ws, (const bf16_t*)ws, DM, DM, DM};
            pg8::SchedKV S{G, bx, (long)WS_MEMB, (long)WS_BIG, (long)(WS_BIG + (size_t)2 * DM * DM * 2)};
            pg8::EpiBf16Sel E{KMEM, VT, (bf16_t*)(ws + WS_KV1), (bf16_t*)(ws + WS_KV1 + 16 * MiB)};
            pg8::gemm_phase(lds, g, S, E, wave);
        }
        __syncthreads();
        GRID_SYNC();

        const bf16_t* KMl = l == 0 ? KMEM : (const bf16_t*)(ws + WS_KV1); const bf16_t* VTl = l == 0 ? VT : (const bf16_t*)(ws + WS_KV1 + 16 * MiB);
        const float lam_init = 0.8f - 0.6f * __expf(-0.3f * (float)l);
        {
            pg8::Gemm g{XBB, Wl + WO_IN, DM, DM, DM}; pg8::Sched2D S; S.init(TOK, NIN, DM, DM, G, bx);
            pg8::EpiBf16A E{BIG, NIN, STATS, CSF + CB_IN, BWF + CB_IN};
            pg8::gemm_phase(lds, g, S, E, wave);
        }
        GRID_SYNC();
        {
            PH_IDS
            const float a1 = wave_sum(P.in[4][l * 64 + lane] * P.in[5][l * 64 + lane], lane);
            const float a2 = wave_sum(P.in[6][l * 64 + lane] * P.in[7][l * 64 + lane], lane);
            const float lam = __int_as_float(__builtin_amdgcn_readfirstlane(__float_as_int(__expf(a1) - __expf(a2) + lam_init)));
            const float* gdf = P.in[8] + l * 128;
            LAS unsigned char* vl = lds + wave * WAVE_LDS;
            const int vgw = (((bx & 7) * (G / 8)) + (bx >> 3)) * NWAVES + wave;
            for (int task = vgw; task < NB * 8 * 32; task += NGW) {
                const int bh = task >> 5, pp = task & 31;
                diff_task(BIG, XB, bh >> 3, bh & 7, pp, lam, 1.f - lam_init, gdf, lane, vl);
                diff_task(BIG, XB, bh >> 3, bh & 7, 63 - pp, lam, 1.f - lam_init, gdf, lane, vl);
            }
            PendingOut pd; pd.valid = 0; pd.op = nullptr; pd.lsep = nullptr; pd.lsev = 0.f;
#pragma unroll
            for (int k = 0; k < 16; ++k) pd.o2[k] = (u32x2){0u, 0u};
            for (int task = vgw; task < 3 * NB * 8 * 64; task += NGW) {
                const int br = task / (NB * 8 * 64), rem = task % (NB * 8 * 64), bh = rem >> 6, idx = rem & 63;
                const int dil = br == 0 ? 1 : (br == 1 ? 4 : 16);
                const int c = idx & (dil - 1), pb = idx / dil;
                bf16_t* po = br == 0 ? PART0 : (br == 1 ? PART1 : XB + 1024);
                dil_task(BIG, po, br == 2 ? DM : 1024, LSE + (size_t)br * TOK * 8, bh >> 3, bh & 7, dil, c, pb, lane, vl, pd);
            }
            flush_pending(pd, lane >> 5);
        }
        __syncthreads();
        GRID_SYNC();
        { PH_IDS
          const float* gdl = P.in[9] + l * 128;
          for (int m = gw; m < TOK; m += 4 * NGW) { float o[4][16], rn[4];
#pragma unroll
              for (int j = 0; j < 4; ++j) { const int mm = m + j * NGW; dil_combine_load(o[j], rn[j], PART0 + (size_t)mm * 1024, PART1 + (size_t)mm * 1024, XB + (size_t)mm * DM + 1024, LSE + (size_t)mm * 8, LSE + (size_t)(TOK + mm) * 8, LSE + (size_t)(2 * TOK + mm) * 8, lane); }
#pragma unroll
              for (int j = 0; j < 4; ++j) { const int mm = m + j * NGW; dil_combine_store(o[j], rn[j], XB + (size_t)mm * DM + 1024, gdl, lane); } } }
        __syncthreads();
        GRID_SYNC();
        {
            pg8::Gemm g{XB, Wl + WO_OUT, DM, DM, DM}; pg8::Sched2D S; S.init(TOK, DM, DM, DM, G, bx);
            pg8::EpiResid<false> E{H, XBB, STATS, PSTAT(0), l == 0 ? IDENT : P.in[21] + (l - 1) * DM, l == 0 ? IDENT + DM : P.in[22] + (l - 1) * DM};
            pg8::gemm_phase(lds, g, S, E, wave);
        }
        GRID_SYNC();
        { PH_IDS
          const int fr = lane & 15, fq = lane >> 4; const int row = gw * 16 + fr; float mu, rs;
          pg8::row_stats(PSTAT(0) + (size_t)row * 64, fq, lane, mu, rs);
          if (fq == 0) { f32x2 o2; o2[0] = mu; o2[1] = rs; ((f32x2*)STATS)[row] = o2; } }
        __syncthreads();
        GRID_SYNC();
        bf16_t* QM = BIG; bf16_t* PM = BIG + (size_t)TOK * DM;
        {
            pg8::Gemm g{XBB, Wl + WO_Q, DM, DM, DM}; pg8::Sched2D S; S.init(TOK, DM, DM, DM, G, bx);
            pg8::EpiBf16A E{QM, DM, STATS, CSF + CB_Q, BWF + CB_Q};
            pg8::gemm_phase(lds, g, S, E, wave);
        }
        GRID_SYNC();
        {
            pg8::Gemm g{QM, KMl, DM, DM, 512}; pg8::SchedScores S{G, ((bx & 7) * (G / 8)) + (bx >> 3)};
            pg8::EpiExp E{PM, RSUM, 0.04419417382415922f};
            pg8::gemm_phase(lds, g, S, E, wave);
        }
        GRID_SYNC();
        {
            pg8::Gemm g{PM, VTl, 1024, MEMT, 256}; pg8::SchedPV S{G, ((bx & 7) * (G / 8)) + (bx >> 3)};
            pg8::EpiDivRow E{XB, RSUM};
            pg8::gemm_phase(lds, g, S, E, wave);
        }
        GRID_SYNC();
        {
            pg8::Gemm g{XB, Wl + WO_O, DM, DM, DM}; pg8::Sched2D S; S.init(TOK, DM, DM, DM, G, bx);
            pg8::EpiResid<false> E{H, XBB, STATS, PSTAT(0), P.in[10] + l * DM, P.in[11] + l * DM};
            pg8::gemm_phase(lds, g, S, E, wave);
        }
        GRID_SYNC();
        { PH_IDS
          const int fr = lane & 15, fq = lane >> 4; const int row = gw * 16 + fr; float mu, rs;
          pg8::row_stats(PSTAT(0) + (size_t)row * 64, fq, lane, mu, rs);
          if (fq == 0) { f32x2 o2; o2[0] = mu; o2[1] = rs; ((f32x2*)STATS)[row] = o2; } }
        __syncthreads();
        GRID_SYNC();
        const float* cw = P.in[18] + (size_t)l * 3 * NUP; const float* cb = P.in[19] + (size_t)l * NUP;
        {
            pg8::Gemm g{XBB, Wl + WO_UP, DM, DM, DM}; pg8::Sched2D S; S.init(TOK, NUP, DM, DM, G, bx);
            pg8::EpiConvGate E{BIG, RAWH, RAWT, cw, cb, STATS, CSF + CB_UP, BWF + CB_UP};
            pg8::gemm_phase(lds, g, S, E, wave);
        }
        GRID_SYNC();
        { PH_IDS
        for (int idx = gt; idx < 512 * 2 * (DFF / 4); idx += NGT) {
            const int c4 = idx % (DFF / 4), r = (idx / (DFF / 4)) & 1, run = idx / (2 * (DFF / 4)), ch = c4 * 4;
            const bool first = (run % 32) == 0;
            f32x4 cv[2];
#pragma unroll
            for (int bj = 0; bj < 2; ++bj) {
                const f32x4 z = (f32x4){0.f, 0.f, 0.f, 0.f};
                const f32x4 h0 = *(const f32x4*)(RAWH + ((size_t)(run * 2 + r) * 2 + bj) * DFF + ch);
                const f32x4 t1 = first ? z : *(const f32x4*)(RAWT + ((size_t)((run - 1) * 2 + 1) * 2 + bj) * DFF + ch);
                const f32x4 t0 = first ? z : *(const f32x4*)(RAWT + ((size_t)((run - 1) * 2 + 0) * 2 + bj) * DFF + ch);
                const f32x4 hh0 = *(const f32x4*)(RAWH + ((size_t)(run * 2 + 0) * 2 + bj) * DFF + ch);
                const f32x4 h1 = (r == 1) ? hh0 : t1, h2 = (r == 1) ? t1 : t0;
                const int cidx = bj * DFF + ch;
                const f32x4 w0 = *(const f32x4*)(cw + cidx), w1 = *(const f32x4*)(cw + NUP + cidx), w2 = *(const f32x4*)(cw + 2 * NUP + cidx), bb = *(const f32x4*)(cb + cidx);
                cv[bj] = w2 * h0 + w1 * h1 + w0 * h2 + bb;
            }
            f32x4 o;
#pragma unroll
            for (int e = 0; e < 4; ++e) o[e] = cv[0][e] / (1.0f + __expf(-cv[0][e])) * cv[1][e];
            u32x2 w; w.x = pk2(o[0], o[1]); w.y = pk2(o[2], o[3]);
            *(u32x2*)(BIG + (size_t)(run * 64 + r) * DFF + ch) = w;
        } }
        __syncthreads();
        GRID_SYNC();
        if (l < NLAYER - 1) {
            pg8::Gemm g{BIG, Wl + WO_DN, DFF, DFF, DFF}; pg8::Sched2D S; S.init(TOK, DM, DFF, DFF, G, bx);
            pg8::EpiResid<false> E{H, XBB, STATS, PSTAT(0), P.in[15] + l * DM, P.in[16] + l * DM};
            pg8::gemm_phase(lds, g, S, E, wave);
        } else {
            pg8::Gemm g{BIG, Wl + WO_DN, DFF, DFF, DFF}; pg8::Sched2D S; S.init(TOK, DM, DFF, DFF, G, bx);
            pg8::EpiResid<true> E{H, XBB, STATS, PSTAT(0), P.in[15] + l * DM, P.in[16] + l * DM};
            pg8::gemm_phase(lds, g, S, E, wave);
        }
        GRID_SYNC();
        if (l < NLAYER - 1) {
        { PH_IDS
          const int fr = lane & 15, fq = lane >> 4; const int row = gw * 16 + fr; float mu, rs;
          pg8::row_stats(PSTAT(0) + (size_t)row * 64, fq, lane, mu, rs);
          if (fq == 0) { f32x2 o2; o2[0] = mu; o2[1] = rs; ((f32x2*)STATS)[row] = o2; } }
        __syncthreads();
        GRID_SYNC();
        }
    }
    { PH_IDS
      for (int m = gw; m < TOK; m += NGW) ln_row(H + (size_t)m * DM, H + (size_t)m * DM, (bf16_t*)nullptr, P.in[21] + (NLAYER - 1) * DM, P.in[22] + (NLAYER - 1) * DM, lane); }
}

extern "C" void kernel_launch(void* const* d_in, const int* in_sizes, int n_in, void* d_out, int out_size, void* d_ws, size_t ws_size, hipStream_t stream) {
    static int grid = 0;
    if (grid == 0) {
        if (n_in != 23 || out_size != TOK * DM || ws_size < WS_END) { fprintf(stderr, "kernel_launch: unexpected problem (n_in %d, out %d, ws %zu)\n", n_in, out_size, ws_size); grid = -1; return; }
        int dev = 0, cus = 0, per_cu = 0;
        (void)hipGetDevice(&dev);
        (void)hipDeviceGetAttribute(&cus, hipDeviceAttributeMultiprocessorCount, dev);
        if (hipFuncSetAttribute((const void*)mega_fwd, hipFuncAttributeMaxDynamicSharedMemorySize, LDS_BYTES) != hipSuccess) { fprintf(stderr, "kernel_launch: hipFuncSetAttribute failed\n"); grid = -1; return; }
        if (hipOccupancyMaxActiveBlocksPerMultiprocessor(&per_cu, (const void*)mega_fwd, NWAVES * 64, LDS_BYTES) != hipSuccess || per_cu < 1) { fprintf(stderr, "kernel_launch: occupancy query says %d\n", per_cu); per_cu = 1; }
        (void)hipGetLastError();
        if (cus < GRID_BLOCKS) { fprintf(stderr, "kernel_launch: built for a %d-CU device, found %d\n", GRID_BLOCKS, cus); grid = -1; return; }
        grid = GRID_BLOCKS;
        fprintf(stderr, "kernel_launch: grid %d (cus %d, per_cu %d)\n", grid, cus, per_cu);
    }
    if (grid < 0) return;
    if (hipMemsetAsync(d_ws, 0, 65536, stream) != hipSuccess) { fprintf(stderr, "kernel_launch: hipMemsetAsync failed\n"); return; }
    Params p{};
    for (int i = 0; i < 23; ++i) p.in[i] = (const float*)d_in[i];
    p.out = (float*)d_out; p.ws = (unsigned char*)d_ws;
    void* args[] = {&p};
    hipError_t e = hipLaunchCooperativeKernel((const void*)mega_fwd, dim3(grid), dim3(NWAVES * 64), args, LDS_BYTES, stream);
    if (e != hipSuccess) fprintf(stderr, "kernel_launch: cooperative launch failed: %s (grid %d)\n", hipGetErrorString(e), grid);
}
```

```cpp
#include <hip/hip_runtime.h>
#include <hip/hip_cooperative_groups.h>
#include <cstdio>
#include <cstdint>
namespace cg = cooperative_groups;

#define LAS __attribute__((address_space(3)))
typedef unsigned short bf16_t;
typedef short bf16x8 __attribute__((ext_vector_type(8)));
typedef float f32x4 __attribute__((ext_vector_type(4)));
typedef float f32x2 __attribute__((ext_vector_type(2)));
typedef unsigned u32x4 __attribute__((ext_vector_type(4)));
typedef unsigned u32x2 __attribute__((ext_vector_type(2)));

constexpr int DM = 2048, NB = 16, SEQ = 2048, TOK = NB * SEQ, NIN = 6144, DFF = 5632, NUP = 2 * DFF, MEML = 256, MEMT = NB * MEML;
constexpr int NLAYER = 2;
constexpr float ALPHA_RES = 1.4142135623730951f;
constexpr float LN_EPS = 1e-5f, RMS_EPS = 1e-5f;
constexpr size_t WO_IN = 0, WO_OUT = WO_IN + (size_t)NIN * DM, WO_Q = WO_OUT + (size_t)DM * DM, WO_O = WO_Q + (size_t)DM * DM,
                 WO_UP = WO_O + (size_t)DM * DM, WO_DN = WO_UP + (size_t)NUP * DM, W_LAYER = WO_DN + (size_t)DM * DFF;
constexpr int NCOLS = NIN + DM + NUP, CB_IN = 0, CB_Q = NIN, CB_UP = NIN + DM;
constexpr size_t MiB = 1u << 20;
constexpr size_t WS_CSF = 65536;
constexpr size_t WS_W = 1 * MiB;
constexpr size_t WS_PSTAT = 115 * MiB;
constexpr size_t WS_STATS = 132 * MiB;
constexpr size_t WS_IDENT = 131 * MiB;
constexpr size_t WS_XBB = 136 * MiB;
constexpr size_t WS_XB = 264 * MiB;
constexpr size_t WS_BIG = 392 * MiB;
constexpr size_t WS_MEMB = 776 * MiB, WS_KMEM = 792 * MiB, WS_VT = 808 * MiB;
constexpr size_t WS_RAWH = 824 * MiB, WS_RAWT = 872 * MiB;
constexpr size_t WS_RSUM = 920 * MiB;
constexpr size_t WS_PART1 = 924 * MiB;
constexpr size_t WS_LSE = 988 * MiB;
constexpr size_t WS_KV1 = 992 * MiB;
constexpr size_t WS_END = 1024 * MiB;
#ifndef PROBE_DUP_PRO
#define PROBE_DUP_PRO 0
#endif
#ifndef PROBE_DUP_LN
#define PROBE_DUP_LN 0
#endif
#ifndef PROBE_DUP_UP
#define PROBE_DUP_UP 0
#endif
#ifndef PROBE_SYNCS
#define PROBE_SYNCS 0
#endif
#ifndef PROBE_DUP_ATTN
#define PROBE_DUP_ATTN 0
#endif
#ifndef PROBE_DUP_INPROJ
#define PROBE_DUP_INPROJ 0
#endif
#ifndef ATTN_DIFF_MFMA
#define ATTN_DIFF_MFMA 1
#endif
#ifndef ATTN_DIL_MFMA
#define ATTN_DIL_MFMA 1
#endif

__device__ __forceinline__ float sx(float v, int mask, int lane) { return __int_as_float(__builtin_amdgcn_ds_bpermute((lane ^ mask) << 2, __float_as_int(v))); }
__device__ __forceinline__ float bflo(unsigned w) { return __uint_as_float(w << 16); }
__device__ __forceinline__ float bfhi(unsigned w) { return __uint_as_float(w & 0xffff0000u); }
namespace pg8 {
constexpr int BM = 256, BK = 64, HALF = 128, HTB = HALF * BK * 2, STAGE_BYTES = 8 * HTB, NXCD = 8, WGM = 8;
__host__ __device__ __forceinline__ int lds_byte(int r, int c) { const int st = (r >> 4) * 2 + (c >> 5), rr = r & 15, cc = c & 31, ob = rr * 64 + cc * 2; return st * 1024 + (ob ^ (((ob >> 9) & 1) << 5)); }
__host__ __device__ __forceinline__ void stage_rc(int b, int& R, int& C) { const int st = b / 1024, sb = b % 1024, swz = sb ^ (((sb >> 9) & 1) << 5); R = (st >> 1) * 16 + swz / 64; C = (st & 1) * 32 + (swz % 64) / 2; }
__host__ __device__ __forceinline__ int perm32(int rho) { const int n = rho >> 4, i = rho & 15; return 8 * (i >> 2) + 4 * n + (i & 3); }

struct Unit { int orow, ocol, aux, pad; long a_off, b_off; };
struct Gemm { const bf16_t* A; const bf16_t* Bt; int lda, ldb, K; };

struct Sched2D {
    int nM, nN, nwg, G, c; long aT, bT;
    __device__ void init(int M, int N, int lda, int ldb, int G_, int c_) { nM = M / BM; nN = N / BM; nwg = nM * nN; G = G_; c = c_; aT = (long)BM * lda * 2; bT = (long)BM * ldb * 2; }
    __device__ bool next(int i, Unit& u) const {
        const long L = (long)i * G + c; if (L >= nwg) return false;
        int wgid = (int)L; { const int q = nwg / NXCD, r = nwg % NXCD, xcd = wgid % NXCD, off = wgid / NXCD; wgid = (xcd < r ? xcd * (q + 1) : r * (q + 1) + (xcd - r) * q) + off; }
        const int nig = WGM * nN, gid = wgid / nig, fm = gid * WGM, gsz = (nM - fm) < WGM ? (nM - fm) : WGM;
        const int pm = fm + ((wgid % nig) % gsz), pn = (wgid % nig) / gsz;
        u.orow = pm * BM; u.ocol = pn * BM; u.aux = 0; u.pad = 0; u.a_off = pm * aT; u.b_off = pn * bT; return true;
    }
};
struct SchedKV {
    int G, c; long memb_off, wkv0, wkv1;
    __device__ bool next(int i, Unit& u) const {
        const long L = (long)i * G + c; if (L >= 512) return false;
        const int which = (int)L >> 7, t = (int)L & 127; const long wkv = (which >> 1) ? wkv1 : wkv0; u.aux = which; u.pad = 0;
        if ((which & 1) == 0) { const int pm = t & 15, pn = t >> 4; u.orow = pm * BM; u.ocol = pn * BM; u.a_off = memb_off + (long)pm * BM * DM * 2; u.b_off = wkv + (long)pn * BM * DM * 2; }
        else { const int pm = t & 7, pn = t >> 3; u.orow = pm * BM; u.ocol = pn * BM; u.a_off = wkv + (long)(DM + pm * BM) * DM * 2; u.b_off = memb_off + (long)pn * BM * DM * 2; }
        return true;
    }
};
struct SchedScores {
    int G, c;
    __device__ bool next(int i, Unit& u) const {
        const long L = (long)i * G + c; if (L >= NB * 4 * 8) return false;
        const int b = (int)L / 32, h = ((int)L / 8) % 4, qt = (int)L % 8;
        u.orow = b * SEQ + qt * 256; u.ocol = h * 256; u.aux = h; u.pad = 0;
        u.a_off = ((long)u.orow * DM + h * 512) * 2; u.b_off = ((long)(b * MEML) * DM + h * 512) * 2; return true;
    }
};
struct SchedPV {
    int G, c;
    __device__ bool next(int i, Unit& u) const {
        const long L = (long)i * G + c; if (L >= NB * 4 * 8 * 2) return false;
        const int b = (int)L / 64, h = ((int)L / 16) % 4, qt = ((int)L / 2) % 8, dt = (int)L % 2;
        u.orow = b * SEQ + qt * 256; u.ocol = h * 512 + dt * 256; u.aux = h; u.pad = 0;
        u.a_off = ((long)u.orow * 1024 + h * 256) * 2; u.b_off = ((long)(h * 512 + dt * 256) * MEMT + b * MEML) * 2; return true;
    }
};

__device__ __forceinline__ unsigned cvt_pk_bf16(float lo, float hi) { unsigned r; asm volatile("v_cvt_pk_bf16_f32 %0, %1, %2" : "=v"(r) : "v"(lo), "v"(hi)); return r; }

struct EpiBf16 {
    static constexpr bool PERM = true;
    bf16_t* O; int ldc; float sc;
    __device__ __forceinline__ void operator()(f32x4 (&acc)[2][2][4][2], const Unit& u, int wr, int wc, int fr, int fq) const {
        const int row0 = u.orow + wr * 64 + fr, col0 = u.ocol + wc * 32 + 8 * fq;
#pragma unroll
        for (int ai = 0; ai < 2; ++ai)
#pragma unroll
            for (int m = 0; m < 4; ++m) { bf16_t* rowp = O + (size_t)(row0 + ai * HALF + m * 16) * ldc + col0;
#pragma unroll
                for (int bj = 0; bj < 2; ++bj) { const f32x4 v0 = acc[ai][bj][m][0] * sc, v1 = acc[ai][bj][m][1] * sc;
                    u32x4 w; w.x = cvt_pk_bf16(v0[0], v0[1]); w.y = cvt_pk_bf16(v0[2], v0[3]); w.z = cvt_pk_bf16(v1[0], v1[1]); w.w = cvt_pk_bf16(v1[2], v1[3]);
                    *(u32x4*)(rowp + bj * HALF) = w; } }
    }
};
__device__ __forceinline__ void row_stats(const float* ps, int fq, int lane, float& mu, float& rs) {
    const f32x4* p = (const f32x4*)(ps + fq * 16);
    const f32x4 a = p[0], b = p[1], c = p[2], d = p[3];
    float s = (a[0] + a[2]) + (b[0] + b[2]) + (c[0] + c[2]) + (d[0] + d[2]);
    float q = (a[1] + a[3]) + (b[1] + b[3]) + (c[1] + c[3]) + (d[1] + d[3]);
    s += sx(s, 16, lane); q += sx(q, 16, lane); s += sx(s, 32, lane); q += sx(q, 32, lane);
    mu = s * (1.f / DM); rs = 1.f / sqrtf(q * (1.f / DM) - mu * mu + LN_EPS);
}
template <bool F32OUT>
struct EpiResid {
    static constexpr bool PERM = true;
    float* hout; bf16_t* xb; const float* ps_prev  ; float* ps_new  ; const float* g; const float* b;
    __device__ __forceinline__ void operator()(f32x4 (&acc)[2][2][4][2], const Unit& u, int wr, int wc, int  , int  ) const {
        int lane; asm volatile("v_mbcnt_lo_u32_b32 %0, -1, 0\n\tv_mbcnt_hi_u32_b32 %0, -1, %0" : "=v"(lane));
        const int fr = lane & 15, fq = lane >> 4;
        const int col0 = u.ocol + wc * 32 + 8 * fq, slot = (u.ocol >> 8) * 4 + wc;
        const int rowb = u.orow + wr * 64 + fr;
        float mu[8], rs[8];
#pragma unroll
        for (int it = 0; it < 8; ++it) { const f32x2 st = *(const f32x2*)(ps_prev + (size_t)(rowb + (it >> 2) * HALF + (it & 3) * 16) * 2); mu[it] = st[0]; rs[it] = st[1]; }
        {
            f32x4 gv[2][2], bv[2][2];
#pragma unroll
            for (int bj = 0; bj < 2; ++bj)
#pragma unroll
                for (int n = 0; n < 2; ++n) { gv[bj][n] = *(const f32x4*)(g + col0 + bj * HALF + n * 4) * ALPHA_RES; bv[bj][n] = *(const f32x4*)(b + col0 + bj * HALF + n * 4) * ALPHA_RES; }
            u32x4 hv[2], hn[2];
#pragma unroll
            for (int bj = 0; bj < 2; ++bj) { hv[bj] = *(const u32x4*)(xb + (size_t)rowb * DM + col0 + bj * HALF); hn[bj] = hv[bj]; }
#pragma unroll
            for (int it = 0; it < 8; ++it) {
                const int ai = it >> 2, m = it & 3;
                if (it < 7) { int rown = rowb + ((it + 1) >> 2) * HALF + ((it + 1) & 3) * 16; asm volatile("" : "+v"(rown));
                    const size_t offn = (size_t)rown * DM + col0;
#pragma unroll
                    for (int bj = 0; bj < 2; ++bj) hn[bj] = *(const u32x4*)(xb + offn + bj * HALF); }
                asm volatile("" : "+v"(hv[0]), "+v"(hv[1]));
#pragma unroll
                for (int bj = 0; bj < 2; ++bj) { const f32x4 h0 = (f32x4){bflo(hv[bj].x), bfhi(hv[bj].x), bflo(hv[bj].y), bfhi(hv[bj].y)}, h1 = (f32x4){bflo(hv[bj].z), bfhi(hv[bj].z), bflo(hv[bj].w), bfhi(hv[bj].w)};
                    acc[ai][bj][m][0] = ((h0 - mu[it]) * rs[it]) * gv[bj][0] + bv[bj][0] + acc[ai][bj][m][0];
                    acc[ai][bj][m][1] = ((h1 - mu[it]) * rs[it]) * gv[bj][1] + bv[bj][1] + acc[ai][bj][m][1]; hv[bj] = hn[bj]; }
            }
        }
#pragma unroll
        for (int ai = 0; ai < 2; ++ai)
#pragma unroll
            for (int m = 0; m < 4; ++m) asm volatile("" : "+v"(acc[ai][0][m][0]), "+v"(acc[ai][0][m][1]), "+v"(acc[ai][1][m][0]), "+v"(acc[ai][1][m][1]));
        int rowb2 = rowb; asm volatile("" : "+v"(rowb2));
#pragma unroll
        for (int it = 0; it < 8; ++it) {
            const int ai = it >> 2, m = it & 3; int row = rowb2 + ai * HALF + m * 16; asm volatile("" : "+v"(row)); const size_t off = (size_t)row * DM + col0;
            float s1 = 0.f, s2 = 0.f;
#pragma unroll
            for (int bj = 0; bj < 2; ++bj) { const f32x4 y0 = acc[ai][bj][m][0], y1 = acc[ai][bj][m][1];
                if (F32OUT) { *(f32x4*)(hout + off + bj * HALF) = y0; *(f32x4*)(hout + off + bj * HALF + 4) = y1; }
                else { s1 += ((y0[0] + y0[1]) + (y0[2] + y0[3])) + ((y1[0] + y1[1]) + (y1[2] + y1[3]));
                    s2 += ((y0[0] * y0[0] + y0[1] * y0[1]) + (y0[2] * y0[2] + y0[3] * y0[3])) + ((y1[0] * y1[0] + y1[1] * y1[1]) + (y1[2] * y1[2] + y1[3] * y1[3]));
                    u32x4 w; w.x = cvt_pk_bf16(y0[0], y0[1]); w.y = cvt_pk_bf16(y0[2], y0[3]); w.z = cvt_pk_bf16(y1[0], y1[1]); w.w = cvt_pk_bf16(y1[2], y1[3]); *(u32x4*)(xb + off + bj * HALF) = w; } }
            if (!F32OUT) { s1 += sx(s1, 16, lane); s2 += sx(s2, 16, lane); s1 += sx(s1, 32, lane); s2 += sx(s2, 32, lane);
                if (fq == 0) { f32x2 o2; o2[0] = s1; o2[1] = s2; *(f32x2*)(ps_new + (size_t)row * 64 + slot * 2) = o2; } }
        }
    }
};
struct EpiBf16A {
    static constexpr bool PERM = true;
    bf16_t* O; int ldc; const float* ps; const float* cs; const float* bw;
    __device__ __forceinline__ void operator()(f32x4 (&acc)[2][2][4][2], const Unit& u, int wr, int wc, int fr, int fq) const {
        const int row0 = u.orow + wr * 64 + fr, col0 = u.ocol + wc * 32 + 8 * fq;
        f32x4 cv[2][2], bv[2][2];
#pragma unroll
        for (int bj = 0; bj < 2; ++bj)
#pragma unroll
            for (int n = 0; n < 2; ++n) { cv[bj][n] = *(const f32x4*)(cs + col0 + bj * HALF + 4 * n); bv[bj][n] = *(const f32x4*)(bw + col0 + bj * HALF + 4 * n); }
#pragma unroll
        for (int ai = 0; ai < 2; ++ai)
#pragma unroll
            for (int m = 0; m < 4; ++m) { const int row = row0 + ai * HALF + m * 16; bf16_t* rowp = O + (size_t)row * ldc + col0;
                const f32x2 st = *(const f32x2*)(ps + (size_t)row * 2); const float rs = st[1], nm = -st[0] * rs;
#pragma unroll
                for (int bj = 0; bj < 2; ++bj) { const f32x4 v0 = acc[ai][bj][m][0] * rs + (cv[bj][0] * nm + bv[bj][0]), v1 = acc[ai][bj][m][1] * rs + (cv[bj][1] * nm + bv[bj][1]);
                    u32x4 w; w.x = cvt_pk_bf16(v0[0], v0[1]); w.y = cvt_pk_bf16(v0[2], v0[3]); w.z = cvt_pk_bf16(v1[0], v1[1]); w.w = cvt_pk_bf16(v1[2], v1[3]);
                    *(u32x4*)(rowp + bj * HALF) = w; } }
    }
};
struct EpiBf16Sel {
    static constexpr bool PERM = true;
    bf16_t *O0, *O1, *O2, *O3;
    __device__ __forceinline__ void operator()(f32x4 (&acc)[2][2][4][2], const Unit& u, int wr, int wc, int fr, int fq) const {
        bf16_t* Ob = u.aux == 0 ? O0 : (u.aux == 1 ? O1 : (u.aux == 2 ? O2 : O3)); const int ld = (u.aux & 1) ? MEMT : DM;
        const int row0 = u.orow + wr * 64 + fr, col0 = u.ocol + wc * 32 + 8 * fq;
#pragma unroll
        for (int ai = 0; ai < 2; ++ai)
#pragma unroll
            for (int m = 0; m < 4; ++m) { bf16_t* rowp = Ob + (size_t)(row0 + ai * HALF + m * 16) * ld + col0;
#pragma unroll
                for (int bj = 0; bj < 2; ++bj) { const f32x4 v0 = acc[ai][bj][m][0], v1 = acc[ai][bj][m][1];
                    u32x4 w; w.x = cvt_pk_bf16(v0[0], v0[1]); w.y = cvt_pk_bf16(v0[2], v0[3]); w.z = cvt_pk_bf16(v1[0], v1[1]); w.w = cvt_pk_bf16(v1[2], v1[3]);
                    *(u32x4*)(rowp + bj * HALF) = w; } }
    }
};
struct EpiExp {
    static constexpr bool PERM = true;
    bf16_t* P; float* rsum; float sc;
    __device__ __forceinline__ void operator()(f32x4 (&acc)[2][2][4][2], const Unit& u, int wr, int wc, int fr, int fq) const {
        const int row0 = u.orow + wr * 64 + fr, col0 = u.ocol + wc * 32 + 8 * fq; const float k2 = sc * 1.4426950408889634f;
#pragma unroll
        for (int ai = 0; ai < 2; ++ai)
#pragma unroll
            for (int m = 0; m < 4; ++m) { const int row = row0 + ai * HALF + m * 16; bf16_t* rowp = P + (size_t)row * 1024 + col0; float s = 0.f;
#pragma unroll
                for (int bj = 0; bj < 2; ++bj) { f32x4 v0 = acc[ai][bj][m][0] * k2, v1 = acc[ai][bj][m][1] * k2;
#pragma unroll
                    for (int e = 0; e < 4; ++e) { v0[e] = __builtin_amdgcn_exp2f(v0[e]); v1[e] = __builtin_amdgcn_exp2f(v1[e]); }
                    s += (v0[0] + v0[1]) + (v0[2] + v0[3]) + (v1[0] + v1[1]) + (v1[2] + v1[3]);
                    u32x4 w; w.x = cvt_pk_bf16(v0[0], v0[1]); w.y = cvt_pk_bf16(v0[2], v0[3]); w.z = cvt_pk_bf16(v1[0], v1[1]); w.w = cvt_pk_bf16(v1[2], v1[3]);
                    *(u32x4*)(rowp + bj * HALF) = w; }
                s += sx(s, 16, fq * 16 + fr); s += sx(s, 32, fq * 16 + fr);
                if (fq == 0) rsum[((size_t)row * 4 + u.aux) * 4 + wc] = s; }
    }
};
struct EpiDivRow {
    static constexpr bool PERM = true;
    bf16_t* O; const float* rsum;
    __device__ __forceinline__ void operator()(f32x4 (&acc)[2][2][4][2], const Unit& u, int wr, int wc, int fr, int fq) const {
        const int row0 = u.orow + wr * 64 + fr, col0 = u.ocol + wc * 32 + 8 * fq;
#pragma unroll
        for (int ai = 0; ai < 2; ++ai)
#pragma unroll
            for (int m = 0; m < 4; ++m) { const int row = row0 + ai * HALF + m * 16; bf16_t* rowp = O + (size_t)row * DM + col0;
                const f32x4 ps = *(const f32x4*)(rsum + ((size_t)row * 4 + u.aux) * 4); const float inv = 1.0f / ((ps[0] + ps[1]) + (ps[2] + ps[3]));
#pragma unroll
                for (int bj = 0; bj < 2; ++bj) { const f32x4 v0 = acc[ai][bj][m][0] * inv, v1 = acc[ai][bj][m][1] * inv;
                    u32x4 w; w.x = cvt_pk_bf16(v0[0], v0[1]); w.y = cvt_pk_bf16(v0[2], v0[3]); w.z = cvt_pk_bf16(v1[0], v1[1]); w.w = cvt_pk_bf16(v1[2], v1[3]);
                    *(u32x4*)(rowp + bj * HALF) = w; } }
    }
};
template <int CTRL> __device__ __forceinline__ float dppf(float old, float src) { return __int_as_float(__builtin_amdgcn_update_dpp(__float_as_int(old), __float_as_int(src), CTRL, 0xf, 0xf, false)); }
struct EpiConvGate {
    static constexpr bool PERM = true;
    bf16_t* act; float* rawH; float* rawT; const float* cw; const float* cb; const float* ps; const float* cs; const float* bw;
    __device__ __forceinline__ void operator()(f32x4 (&acc)[2][2][4][2], const Unit& u, int wr, int wc, int fr, int fq) const {
        const int chb = (u.ocol >> 1) + wc * 32 + 8 * fq;
        {
            const int colq = u.ocol + wc * 32 + 8 * fq;
            float nmv[2][4], rsv[2][4];
#pragma unroll
            for (int ai = 0; ai < 2; ++ai)
#pragma unroll
                for (int m = 0; m < 4; ++m) { const f32x2 st = *(const f32x2*)(ps + (size_t)(u.orow + ai * HALF + wr * 64 + m * 16 + fr) * 2); rsv[ai][m] = st[1]; nmv[ai][m] = -st[0] * st[1]; }
#pragma unroll
            for (int bj = 0; bj < 2; ++bj)
#pragma unroll
                for (int n = 0; n < 2; ++n) { f32x4 cv = *(const f32x4*)(cs + colq + bj * HALF + 4 * n), bv = *(const f32x4*)(bw + colq + bj * HALF + 4 * n);
                    asm volatile("" : "+v"(cv), "+v"(bv));
#pragma unroll
                    for (int ai = 0; ai < 2; ++ai)
#pragma unroll
                        for (int m = 0; m < 4; ++m) acc[ai][bj][m][n] = acc[ai][bj][m][n] * rsv[ai][m] + (cv * nmv[ai][m] + bv); }
        }
#pragma unroll
        for (int ai = 0; ai < 2; ++ai) { const int run = (u.orow + ai * HALF + wr * 64) >> 6;
#pragma unroll
            for (int bj = 0; bj < 2; ++bj)
#pragma unroll
                for (int n = 0; n < 2; ++n) {
                    if (fr < 2) *(f32x4*)(rawH + ((size_t)(run * 2 + fr) * 2 + bj) * DFF + chb + 4 * n) = acc[ai][bj][0][n];
                    if (fr >= 14) *(f32x4*)(rawT + ((size_t)(run * 2 + fr - 14) * 2 + bj) * DFF + chb + 4 * n) = acc[ai][bj][3][n]; } }
        f32x4 w0, w1, w2, bb, nw0, nw1, nw2, nbb;
        { w0 = *(const f32x4*)(cw + chb); w1 = *(const f32x4*)(cw + NUP + chb); w2 = *(const f32x4*)(cw + 2 * NUP + chb); bb = *(const f32x4*)(cb + chb); nw0 = w0; nw1 = w1; nw2 = w2; nbb = bb; }
#pragma unroll
        for (int blk = 0; blk < 8; ++blk) {
            const int ai = blk >> 2, bj = (blk >> 1) & 1, n = blk & 1;
            if (blk < 7) { int chb_ = chb; asm volatile("" : "+v"(chb_));
                const int cidx = (((blk + 1) >> 1) & 1) * DFF + chb_ + 4 * ((blk + 1) & 1);
                nw0 = *(const f32x4*)(cw + cidx); nw1 = *(const f32x4*)(cw + NUP + cidx); nw2 = *(const f32x4*)(cw + 2 * NUP + cidx); nbb = *(const f32x4*)(cb + cidx); }
            asm volatile("" : "+v"(w0), "+v"(w1), "+v"(w2), "+v"(bb));
#pragma unroll
            for (int m = 3; m >= 0; --m) {
                f32x4 v = acc[ai][bj][m][n]; f32x4 pv = (m > 0) ? acc[ai][bj][m > 0 ? m - 1 : 0][n] : (f32x4){0.f, 0.f, 0.f, 0.f};
                asm volatile("" : "+v"(v), "+v"(pv));
                f32x4 r;
#pragma unroll
                for (int e = 0; e < 4; ++e) {
                    const float o1 = dppf<0x121>(0.f, pv[e]), o2 = dppf<0x122>(0.f, pv[e]);
                    const float p1 = dppf<0x111>(o1, v[e]), p2 = dppf<0x112>(o2, v[e]);
                    r[e] = w2[e] * v[e] + w1[e] * p1 + w0[e] * p2 + bb[e];
                }
                asm volatile("" : "+v"(r));
                acc[ai][bj][m][n] = r;
            }
            w0 = nw0; w1 = nw1; w2 = nw2; bb = nbb;
        }
#pragma unroll
        for (int ai = 0; ai < 2; ++ai)
#pragma unroll
            for (int m = 0; m < 4; ++m) { int row = u.orow + ai * HALF + wr * 64 + m * 16 + fr; asm volatile("" : "+v"(row)); f32x4 o[2];
#pragma unroll
                for (int n = 0; n < 2; ++n) { const f32x4 g = acc[ai][0][m][n], up = acc[ai][1][m][n];
#pragma unroll
                    for (int e = 0; e < 4; ++e) o[n][e] = g[e] * __builtin_amdgcn_rcpf(1.0f + __builtin_amdgcn_exp2f(-1.4426950408889634f * g[e])) * up[e]; }
                u32x4 w; w.x = cvt_pk_bf16(o[0][0], o[0][1]); w.y = cvt_pk_bf16(o[0][2], o[0][3]); w.z = cvt_pk_bf16(o[1][0], o[1][1]); w.w = cvt_pk_bf16(o[1][2], o[1][3]);
                *(u32x4*)(act + (size_t)row * DFF + chb) = w; }
    }
};

__device__ __forceinline__ void glds16s(const void* sbase_, unsigned voff, unsigned lds_dst) { unsigned keep;
    const unsigned long long pb_ = (unsigned long long)sbase_;
    const void* sbase = (const void*)(((unsigned long long)(unsigned)__builtin_amdgcn_readfirstlane((int)(pb_ >> 32)) << 32) | (unsigned)__builtin_amdgcn_readfirstlane((int)pb_));
    asm volatile("s_mov_b32 %0, m0\n\ts_mov_b32 m0, %3\n\ts_nop 0\n\tglobal_load_lds_dwordx4 %1, %2\n\ts_mov_b32 m0, %0" : "=&s"(keep) : "v"(voff), "s"(sbase), "s"(lds_dst) : "memory"); }
template <class Epi, class Sched>
__device__ __forceinline__ void gemm_phase(LAS unsigned char* lds, const Gemm g, const Sched& S, const Epi& E, int wave_id) {
    int lane_; asm volatile("v_mbcnt_lo_u32_b32 %0, -1, 0\n\tv_mbcnt_hi_u32_b32 %0, -1, %0" : "=v"(lane_));
    int wid_ = wave_id; asm volatile("" : "+s"(wid_));
    const int wid = wid_, lane = lane_, tid = wid * 64 + lane, wr = wid >> 2, wc = wid & 3, fr = lane & 15, fq = lane >> 4;
    const int nt = g.K / BK;
    unsigned voffA[2], voffB[2];
#pragma unroll
    for (int i = 0; i < 2; ++i) { int R, C; stage_rc(tid * 16 + i * 8192, R, C); const int Rb = Epi::PERM ? ((R & ~31) + perm32(R & 31)) : R;
        voffA[i] = (unsigned)(R * g.lda + C) * 2u; voffB[i] = (unsigned)(Rb * g.ldb + C) * 2u; }
    const size_t kstep = (size_t)(BK * 2);
    const size_t hA = (size_t)HALF * g.lda * 2, hB = (size_t)HALF * g.ldb * 2;
    const unsigned ldsw = (unsigned)wid * 1024u, ldsbase = (unsigned)(unsigned long)lds;
    const int aoff = lds_byte(wr * 64 + fr, fq * 8), boff = lds_byte(wc * 32 + fr, fq * 8);
#define PG8_SA(b, h) (((b) * 2 + (h)) * HTB)
#define PG8_SB(b, h) ((4 + (b) * 2 + (h)) * HTB)
#define PG8_STAGE(bufoff, gbase, voff) do { _Pragma("unroll") for (int _i = 0; _i < 2; ++_i) \
        glds16s((const void*)(gbase), (voff)[_i], (unsigned)__builtin_amdgcn_readfirstlane((int)(ldsbase + (unsigned)(bufoff) + ldsw + _i * 8192u))); } while (0)
#define PG8_LDA(dst, b, h) do { _Pragma("unroll") for (int m = 0; m < 4; ++m) _Pragma("unroll") for (int k = 0; k < 2; ++k) dst[m][k] = *(const LAS bf16x8*)(lds + PG8_SA(b, h) + aoff + m * 2048 + k * 1024); } while (0)
#define PG8_LDB(dst, b, h) do { _Pragma("unroll") for (int n = 0; n < 2; ++n) _Pragma("unroll") for (int k = 0; k < 2; ++k) dst[n][k] = *(const LAS bf16x8*)(lds + PG8_SB(b, h) + boff + n * 2048 + k * 1024); } while (0)
#define PG8_MMA(ai, bj, At, Bt) do { __builtin_amdgcn_s_setprio(1); _Pragma("unroll") for (int m = 0; m < 4; ++m) _Pragma("unroll") for (int n = 0; n < 2; ++n) _Pragma("unroll") for (int k = 0; k < 2; ++k) \
        acc[ai][bj][m][n] = __builtin_amdgcn_mfma_f32_16x16x32_bf16(Bt[n][k], At[m][k], acc[ai][bj][m][n], 0, 0, 0); __builtin_amdgcn_s_setprio(0); } while (0)
#define PG8_WAIT_V(n) asm volatile("s_waitcnt vmcnt(" #n ")" ::: "memory")
#define PG8_WAIT_L(n) asm volatile("s_waitcnt lgkmcnt(" #n ")" ::: "memory")
#define PG8_BAR __builtin_amdgcn_s_barrier()
#define PG8_SCHED __builtin_amdgcn_sched_barrier(0)
    Unit cur, nxt; int ui = 0;
    if (!S.next(0, cur)) return;
    f32x4 acc[2][2][4][2];
#pragma unroll
    for (int a = 0; a < 2; ++a)
#pragma unroll
        for (int b = 0; b < 2; ++b)
#pragma unroll
            for (int m = 0; m < 4; ++m)
#pragma unroll
                for (int n = 0; n < 2; ++n) acc[a][b][m][n] = (f32x4){0.f, 0.f, 0.f, 0.f};
    bf16x8 At[4][2], B0[2][2], B1[2][2];
    const char* cA = (const char*)g.A + cur.a_off; const char* cB = (const char*)g.Bt + cur.b_off;
    PG8_STAGE(PG8_SB(0, 0), cB, voffB); PG8_STAGE(PG8_SB(0, 1), cB + hB, voffB); PG8_STAGE(PG8_SA(0, 0), cA, voffA); PG8_STAGE(PG8_SA(0, 1), cA + hA, voffA);
    if (wr == 1) PG8_BAR;
    PG8_WAIT_V(2); PG8_BAR;
    PG8_STAGE(PG8_SB(1, 0), cB + kstep, voffB); PG8_STAGE(PG8_SA(1, 0), cA + kstep, voffA); PG8_STAGE(PG8_SB(1, 1), cB + hB + kstep, voffB);
    PG8_WAIT_V(6); PG8_BAR;
    for (;;) {
        const bool has_next = S.next(ui + 1, nxt);
        const char* nA = has_next ? (const char*)g.A + nxt.a_off : cA; const char* nB = has_next ? (const char*)g.Bt + nxt.b_off : cB;
        for (int t = 0; t < nt; t += 2) {
            const bool last = (t == nt - 2);
            const char* a1 = cA + (size_t)(t + 1) * kstep;
            const char* a2 = last ? nA : cA + (size_t)(t + 2) * kstep; const char* b2 = last ? nB : cB + (size_t)(t + 2) * kstep;
            const char* a3 = a2 + kstep; const char* b3 = b2 + kstep;
            PG8_LDB(B0, 0, 0); PG8_LDB(B1, 0, 1); PG8_SCHED; PG8_LDA(At, 0, 0); PG8_STAGE(PG8_SA(1, 1), a1 + hA, voffA);
            PG8_WAIT_V(8); PG8_WAIT_L(0); PG8_BAR; PG8_MMA(0, 0, At, B0); PG8_MMA(0, 1, At, B1); PG8_BAR; PG8_SCHED;
            PG8_LDA(At, 0, 1); PG8_STAGE(PG8_SB(0, 0), b2, voffB); PG8_STAGE(PG8_SB(0, 1), b2 + hB, voffB); PG8_STAGE(PG8_SA(0, 0), a2, voffA);
            PG8_WAIT_V(8); PG8_WAIT_L(0); PG8_BAR; PG8_MMA(1, 0, At, B0); PG8_MMA(1, 1, At, B1); PG8_BAR; PG8_SCHED;
            PG8_LDB(B0, 1, 0); PG8_LDB(B1, 1, 1); PG8_SCHED; PG8_LDA(At, 1, 0); PG8_STAGE(PG8_SA(0, 1), a2 + hA, voffA);
            PG8_WAIT_V(8); PG8_WAIT_L(0); PG8_BAR; PG8_MMA(0, 0, At, B0); PG8_MMA(0, 1, At, B1); PG8_BAR; PG8_SCHED;
            PG8_LDA(At, 1, 1); PG8_STAGE(PG8_SB(1, 0), b3, voffB); PG8_STAGE(PG8_SB(1, 1), b3 + hB, voffB); PG8_STAGE(PG8_SA(1, 0), a3, voffA);
            PG8_WAIT_V(8); PG8_WAIT_L(0); PG8_BAR; PG8_MMA(1, 0, At, B0); PG8_MMA(1, 1, At, B1); PG8_BAR; PG8_SCHED;
        }
        if (wr == 0) PG8_BAR;
        E(acc, cur, wr, wc, fr, fq);
        if (!has_next) break;
#pragma unroll
        for (int a = 0; a < 2; ++a)
#pragma unroll
            for (int b = 0; b < 2; ++b)
#pragma unroll
                for (int m = 0; m < 4; ++m)
#pragma unroll
                    for (int n = 0; n < 2; ++n) acc[a][b][m][n] = (f32x4){0.f, 0.f, 0.f, 0.f};
        cur = nxt; cA = nA; cB = nB; ++ui;
        if (wr == 1) PG8_BAR;
    }
    PG8_WAIT_V(0);
    PG8_BAR;
#undef PG8_SA
#undef PG8_SB
#undef PG8_STAGE
#undef PG8_LDA
#undef PG8_LDB
#undef PG8_MMA
#undef PG8_WAIT_V
#undef PG8_WAIT_L
#undef PG8_BAR
#undef PG8_SCHED
}
}

__device__ __forceinline__ unsigned f2bf(float f) { unsigned u = __builtin_bit_cast(unsigned, f); return (u + 0x7fffu + ((u >> 16) & 1u)) >> 16; }
__device__ __forceinline__ unsigned pk2(float lo, float hi) { return f2bf(lo) | (f2bf(hi) << 16); }
__device__ __forceinline__ float wave_sum(float v, int lane) {
#pragma unroll
    for (int o = 1; o < 64; o <<= 1) v += sx(v, o, lane);
    return v;
}
#define LDS_WAIT() asm volatile("s_waitcnt lgkmcnt(0)" ::: "memory")

struct Params {
    const float* in[23]; float* out; unsigned char* ws;
};

__device__ __forceinline__ void transpose_item(const float* W, int K, int N, bf16_t* WT, int mode, LAS float* scr, int item, int lane, const float* gvec, const float* bvec, float* csp, int nblk, int nmagic) {
    const int kb = (item * nmagic) >> 20, nb = item - kb * nblk, k0 = 64 * kb, n0 = 64 * nb;
    int r0 = n0;
    if (mode == 1) { const int bj = n0 / DFF, rem = n0 % DFF; r0 = 256 * (rem / 128) + 128 * bj + (rem % 128); }
    const int rr = lane >> 4, q = lane & 15;
    f32x4 t[16];
#pragma unroll
    for (int i = 0; i < 16; ++i) t[i] = *(const f32x4*)(W + (size_t)(k0 + 4 * i + rr) * N + n0 + 4 * q);
#pragma unroll
    for (int i = 0; i < 16; ++i) { LAS float* d = scr + (4 * i + rr) * 65 + 4 * q; d[0] = t[i][0]; d[1] = t[i][1]; d[2] = t[i][2]; d[3] = t[i][3]; }
    LDS_WAIT(); asm volatile("" ::: "memory");
    const int c = lane & 7;
    if (csp) {
        f32x4 g0 = (f32x4){1.f, 1.f, 1.f, 1.f}, g1 = g0, b0 = (f32x4){0.f, 0.f, 0.f, 0.f}, b1 = b0;
        if (gvec) { g0 = *(const f32x4*)(gvec + k0 + 8 * c); g1 = *(const f32x4*)(gvec + k0 + 8 * c + 4); b0 = *(const f32x4*)(bvec + k0 + 8 * c); b1 = *(const f32x4*)(bvec + k0 + 8 * c + 4); }
#pragma unroll
        for (int j = 0; j < 8; ++j) { const int n = (lane >> 3) + 8 * j; const LAS float* sp = scr + (8 * c) * 65 + n;
            const float w0 = sp[0 * 65], w1 = sp[1 * 65], w2 = sp[2 * 65], w3 = sp[3 * 65], w4 = sp[4 * 65], w5 = sp[5 * 65], w6 = sp[6 * 65], w7 = sp[7 * 65];
            u32x4 o; o.x = pk2(w0 * g0[0], w1 * g0[1]); o.y = pk2(w2 * g0[2], w3 * g0[3]); o.z = pk2(w4 * g1[0], w5 * g1[1]); o.w = pk2(w6 * g1[2], w7 * g1[3]);
            *(u32x4*)(WT + (size_t)(r0 + n) * K + k0 + 8 * c) = o;
            float cs = ((bflo(o.x) + bfhi(o.x)) + (bflo(o.y) + bfhi(o.y))) + ((bflo(o.z) + bfhi(o.z)) + (bflo(o.w) + bfhi(o.w)));
            float bs = ((w0 * b0[0] + w1 * b0[1]) + (w2 * b0[2] + w3 * b0[3])) + ((w4 * b1[0] + w5 * b1[1]) + (w6 * b1[2] + w7 * b1[3]));
            cs += sx(cs, 1, lane); bs += sx(bs, 1, lane); cs += sx(cs, 2, lane); bs += sx(bs, 2, lane); cs += sx(cs, 4, lane); bs += sx(bs, 4, lane);
            if (c == 0) { f32x2 o2; o2[0] = cs; o2[1] = bs; *(f32x2*)(csp + ((size_t)kb * NCOLS + r0 + n) * 2) = o2; } }
    } else {
#pragma unroll
        for (int j = 0; j < 8; ++j) { const int n = (lane >> 3) + 8 * j; const LAS float* sp = scr + (8 * c) * 65 + n;
            u32x4 o; o.x = pk2(sp[0 * 65], sp[1 * 65]); o.y = pk2(sp[2 * 65], sp[3 * 65]); o.z = pk2(sp[4 * 65], sp[5 * 65]); o.w = pk2(sp[6 * 65], sp[7 * 65]);
            *(u32x4*)(WT + (size_t)(r0 + n) * K + k0 + 8 * c) = o; }
    }
    LDS_WAIT(); asm volatile("" ::: "memory");
}

__device__ __forceinline__ void ln_row_bf(const float* xin, bf16_t* ybf, float* stat, const float* g, const float* b, int lane) {
    const f32x4* xr = (const f32x4*)xin + lane;
    f32x4 v[8]; float s = 0.f;
#pragma unroll
    for (int j = 0; j < 8; ++j) { v[j] = xr[64 * j]; s += (v[j][0] + v[j][1]) + (v[j][2] + v[j][3]); }
    const float mean = wave_sum(s, lane) * (1.f / DM); float s2 = 0.f;
#pragma unroll
    for (int j = 0; j < 8; ++j) { v[j] = v[j] - mean; s2 += (v[j][0] * v[j][0] + v[j][1] * v[j][1]) + (v[j][2] * v[j][2] + v[j][3] * v[j][3]); }
    const float rstd = 1.f / sqrtf(wave_sum(s2, lane) * (1.f / DM) + LN_EPS);
    if (lane == 0) { stat[0] = mean; stat[1] = rstd; }
    u32x2* o8 = (u32x2*)ybf + lane;
#pragma unroll
    for (int j = 0; j < 8; ++j) { const f32x4 gg = ((const f32x4*)g)[lane + 64 * j], bb = ((const f32x4*)b)[lane + 64 * j];
        const f32x4 y = v[j] * rstd * gg + bb; u32x2 w; w.x = pk2(y[0], y[1]); w.y = pk2(y[2], y[3]); o8[64 * j] = w; }
}
__device__ __forceinline__ void ln_row(const float* xin, float* yout, bf16_t* ybf, const float* g, const float* b, int lane) {
    const f32x4* xr = (const f32x4*)xin + lane;
    f32x4 v[8]; float s = 0.f;
#pragma unroll
    for (int j = 0; j < 8; ++j) { v[j] = xr[64 * j]; s += (v[j][0] + v[j][1]) + (v[j][2] + v[j][3]); }
    const float mean = wave_sum(s, lane) * (1.f / DM); float s2 = 0.f;
#pragma unroll
    for (int j = 0; j < 8; ++j) { v[j] = v[j] - mean; s2 += (v[j][0] * v[j][0] + v[j][1] * v[j][1]) + (v[j][2] * v[j][2] + v[j][3] * v[j][3]); }
    const float rstd = 1.f / sqrtf(wave_sum(s2, lane) * (1.f / DM) + LN_EPS);
    f32x4* yo = (f32x4*)yout + lane; u32x2* o8 = (u32x2*)ybf + lane;
#pragma unroll
    for (int j = 0; j < 8; ++j) { const f32x4 gg = ((const f32x4*)g)[lane + 64 * j], bb = ((const f32x4*)b)[lane + 64 * j];
        const f32x4 y = v[j] * rstd * gg + bb; yo[64 * j] = y; if (ybf) { u32x2 w; w.x = pk2(y[0], y[1]); w.y = pk2(y[2], y[3]); o8[64 * j] = w; } }
}

template <bool DO_DIFF, bool DO_DIL>
__device__ __forceinline__ void simple_attn_task(const bf16_t* proj, bf16_t* xo, int b, int h, int qb16, float lam, float lam_init, const float* g_diff, const float* g_dil, int lane, LAS float* resl) {
    const int ql = lane & 15, dvq = lane >> 4;
    const int t = qb16 * 16 + ql;
    const size_t rowb = (size_t)b * SEQ;
    const bf16_t* qrow = proj + (rowb + t) * NIN;
    if constexpr (DO_DIFF) {
        const float slope = exp2f(-(float)(2 * h + 1) * 0.5f);
#pragma unroll 1
        for (int c = 0; c < 2; ++c) {
            asm volatile("" ::: "memory");
            unsigned q[32];
            { const u32x4* qp = (const u32x4*)(qrow + h * 128 + c * 64);
#pragma unroll
              for (int i = 0; i < 8; ++i) { const u32x4 w = qp[i]; q[4 * i] = w[0]; q[4 * i + 1] = w[1]; q[4 * i + 2] = w[2]; q[4 * i + 3] = w[3]; } }
            float o[32];
#pragma unroll
            for (int d = 0; d < 32; ++d) o[d] = 0.f;
            float m = -1e30f, l = 0.f;
            const int kend = qb16 * 16 + 16;
#pragma unroll 1
            for (int k = 0; k < kend; ++k) {
                const bf16_t* krow = proj + (rowb + k) * NIN;
                const u32x4* kp = (const u32x4*)(krow + 1024 + h * 128 + c * 64);
                float s = 0.f;
#pragma unroll
                for (int i = 0; i < 8; ++i) { const u32x4 w = kp[i];
#pragma unroll
                    for (int e = 0; e < 4; ++e) { s += bflo(q[4 * i + e]) * bflo(w[e]); s += bfhi(q[4 * i + e]) * bfhi(w[e]); } }
                s = s * 0.125f - slope * (float)(t - k);
                asm volatile("" : "+v"(s) :: "memory");
                if (k <= t) {
                    if (s > m) { const float a = __expf(m - s); l *= a;
#pragma unroll
                        for (int d = 0; d < 32; ++d) o[d] *= a;
                        m = s; }
                    const float pr = __expf(s - m); l += pr;
                    const u32x4* vp = (const u32x4*)(krow + 2048 + h * 128 + dvq * 32);
#pragma unroll
                    for (int i = 0; i < 4; ++i) { const u32x4 w = vp[i];
#pragma unroll
                        for (int e = 0; e < 4; ++e) { o[8 * i + 2 * e] += pr * bflo(w[e]); o[8 * i + 2 * e + 1] += pr * bfhi(w[e]); } }
                }
            }
            const float inv = 1.f / l;
            if (c == 0) {
#pragma unroll
                for (int d = 0; d < 32; ++d) resl[d * 512] = o[d] * inv;
            } else {
                float ss = 0.f;
#pragma unroll
                for (int d = 0; d < 32; ++d) { if ((d & 7) == 0) asm volatile("" ::: "memory"); o[d] = resl[d * 512] - lam * o[d] * inv; ss += o[d] * o[d]; }
                ss += sx(ss, 16, lane); ss += sx(ss, 32, lane);
                const float r = (1.f / sqrtf(ss * (1.f / 128.f) + RMS_EPS)) * (1.f - lam_init);
                unsigned* op = (unsigned*)(xo + (rowb + t) * DM + h * 128 + dvq * 32);
#pragma unroll
                for (int d = 0; d < 32; d += 2) { if ((d & 7) == 0) asm volatile("" ::: "memory"); op[d >> 1] = pk2(o[d] * r * g_diff[dvq * 32 + d], o[d + 1] * r * g_diff[dvq * 32 + d + 1]); }
            }
        }
    }
    if constexpr (DO_DIL) {
        asm volatile("" ::: "memory");
        const float slope = exp2f(-(float)(h + 1));
        const float scale = 0.08838834764831845f;
        unsigned qpk[64];
        { const u32x4* qp = (const u32x4*)(qrow + 3072 + h * 128);
#pragma unroll
          for (int i = 0; i < 16; ++i) { const u32x4 w = qp[i]; qpk[4 * i] = w[0]; qpk[4 * i + 1] = w[1]; qpk[4 * i + 2] = w[2]; qpk[4 * i + 3] = w[3]; } }
        float o[32];
#pragma unroll
        for (int d = 0; d < 32; ++d) o[d] = 0.f;
        float m = -1e30f, l = 0.f;
#pragma unroll 1
        for (int br = 0; br < 3; ++br) {
            const int dil = br == 0 ? 1 : (br == 1 ? 4 : 16);
            const int p = t / dil;
#pragma unroll 1
            for (int j = 0; j <= 128; ++j) {
                if (j <= p) {
                    const int k = t - j * dil;
                    const bf16_t* krow = proj + (rowb + k) * NIN;
                    const u32x4* kp = (const u32x4*)(krow + 4096 + h * 128);
                    float s = 0.f;
#pragma unroll
                    for (int i = 0; i < 16; ++i) { const u32x4 w = kp[i];
#pragma unroll
                        for (int e = 0; e < 4; ++e) { s += bflo(qpk[4 * i + e]) * bflo(w[e]); s += bfhi(qpk[4 * i + e]) * bfhi(w[e]); } }
                    s = s * scale - slope * (float)(j * dil);
                    asm volatile("" : "+v"(s) :: "memory");
                    if (s > m) { const float a = __expf(m - s); l *= a;
#pragma unroll
                        for (int d = 0; d < 32; ++d) o[d] *= a;
                        m = s; }
                    const float pr = __expf(s - m); l += pr;
                    const u32x4* vp = (const u32x4*)(krow + 5120 + h * 128 + dvq * 32);
#pragma unroll
                    for (int i = 0; i < 4; ++i) { const u32x4 w = vp[i];
#pragma unroll
                        for (int e = 0; e < 4; ++e) { o[8 * i + 2 * e] += pr * bflo(w[e]); o[8 * i + 2 * e + 1] += pr * bfhi(w[e]); } }
                }
            }
        }
        const float inv = 1.f / l; float ss = 0.f;
#pragma unroll
        for (int d = 0; d < 32; ++d) { o[d] *= inv; ss += o[d] * o[d]; }
        ss += sx(ss, 16, lane); ss += sx(ss, 32, lane);
        const float r = 1.f / sqrtf(ss * (1.f / 128.f) + RMS_EPS);
        unsigned* op = (unsigned*)(xo + (rowb + t) * DM + 1024 + h * 128 + dvq * 32);
#pragma unroll
        for (int d = 0; d < 32; d += 2) { if ((d & 7) == 0) asm volatile("" ::: "memory"); op[d >> 1] = pk2(o[d] * r * g_dil[dvq * 32 + d], o[d + 1] * r * g_dil[dvq * 32 + d + 1]); }
    }
}


typedef float f32x16 __attribute__((ext_vector_type(16)));
typedef short s16x4 __attribute__((ext_vector_type(4)));
#define MFMA32(a, b, c) __builtin_amdgcn_mfma_f32_32x32x16_bf16((a), (b), (c), 0, 0, 0)
constexpr int VROWB = 320;
constexpr float LOG2E = 1.4426950408889634f, NEGBIG = -1e30f;
__device__ __forceinline__ s16x4 vtr(const LAS unsigned char* p) { return __builtin_bit_cast(s16x4, __builtin_amdgcn_ds_read_tr16_b64_v4i16((LAS s16x4*)p)); }
__device__ __forceinline__ int crow(int r, int hi) { return (r & 3) + 8 * (r >> 2) + 4 * hi; }
__device__ __forceinline__ void load_v(u32x4 (&t)[8], const bf16_t* vbase  , int rstride, unsigned voff  ) {
#pragma unroll
    for (int i = 0; i < 8; ++i) t[i] = *(const u32x4*)((const char*)(vbase + (size_t)(4 * i * rstride) * NIN) + voff);
}
__device__ __forceinline__ void store_v(LAS unsigned char* vl, const u32x4 (&t)[8], int lane) {
    const int rr = lane >> 4, ch = lane & 15;
#pragma unroll
    for (int i = 0; i < 8; ++i) *(LAS u32x4*)(vl + (4 * i + rr) * VROWB + ch * 16) = t[i];
}
constexpr int KROWB = 272;
constexpr int WAVE_LDS = 32 * VROWB + 32 * KROWB;
__device__ __forceinline__ void store_k(LAS unsigned char* kl, const u32x4 (&t)[8], int lane) {
    const int rr = lane >> 4, ch = lane & 15;
#pragma unroll
    for (int i = 0; i < 8; ++i) *(LAS u32x4*)(kl + (4 * i + rr) * KROWB + ch * 16) = t[i];
}
__device__ __forceinline__ void read_kf(bf16x8 (&kf)[8], const LAS unsigned char* klane  ) {
#pragma unroll
    for (int d0 = 0; d0 < 8; ++d0) kf[d0] = *(const LAS bf16x8*)(klane + 32 * d0);
}
__device__ __forceinline__ void pv_chunk(f32x16 (&ot)[4], const LAS unsigned char* vtb, bf16x8 pf0, bf16x8 pf1) {
#pragma unroll
    for (int db = 0; db < 4; ++db)
#pragma unroll
        for (int s = 0; s < 2; ++s) {
            const s16x4 a = vtr(vtb + (16 * s) * VROWB + 64 * db), b2 = vtr(vtb + (16 * s + 8) * VROWB + 64 * db);
            const bf16x8 vf = (bf16x8){a[0], a[1], a[2], a[3], b2[0], b2[1], b2[2], b2[3]};
            __builtin_amdgcn_s_setprio(1); ot[db] = MFMA32(vf, s ? pf1 : pf0, ot[db]); __builtin_amdgcn_s_setprio(0);
        }
}
__device__ __forceinline__ bf16x8 pack8(const float* p) {
    u32x4 w; w.x = pg8::cvt_pk_bf16(p[0], p[1]); w.y = pg8::cvt_pk_bf16(p[2], p[3]); w.z = pg8::cvt_pk_bf16(p[4], p[5]); w.w = pg8::cvt_pk_bf16(p[6], p[7]);
    return __builtin_bit_cast(bf16x8, w);
}
__device__ __forceinline__ void store_rows_wide(bf16_t* op  , u32x2 (&o2)[16], int hi) {
#pragma unroll
    for (int k = 0; k < 16; k += 2) { u32x2 a = o2[k], b = o2[k + 1];
        { auto r = __builtin_amdgcn_permlane32_swap(a.x, b.x, false, false); a.x = r[0]; b.x = r[1]; }
        { auto r = __builtin_amdgcn_permlane32_swap(a.y, b.y, false, false); a.y = r[0]; b.y = r[1]; }
        u32x4 w; w.x = a.x; w.y = a.y; w.z = b.x; w.w = b.y;
        *(u32x4*)(op + 8 * k + 8 * hi) = w; }
}
__device__ __forceinline__ void diff_task(const bf16_t* proj, bf16_t* xo, int b, int h, int qb, float lam, float post, const float* g_diff, int  , LAS unsigned char* vl) {
    int lane; asm volatile("v_mbcnt_lo_u32_b32 %0, -1, 0\n\tv_mbcnt_hi_u32_b32 %0, -1, %0" : "=v"(lane));
    const int r32 = lane & 31, hi = lane >> 5;
    const size_t rowb = (size_t)b * SEQ;
    const int qpos = qb * 32 + r32;
    const float slope = exp2f(-(float)(2 * h + 1) * 0.5f);
    const float c1 = 0.125f * LOG2E, c2 = slope * LOG2E, c2s = c2 * 32.f;
    bf16x8 qf[8];
    { const bf16_t* qp = proj + (rowb + qpos) * NIN + h * 128 + 8 * hi;
#pragma unroll
      for (int d0 = 0; d0 < 8; ++d0) qf[d0] = *(const bf16x8*)(qp + 16 * d0); }
    const bf16_t* kcol = proj + 1024 + h * 128 + rowb * NIN;
    const bf16_t* vcol = proj + 2048 + h * 128 + rowb * NIN;
    const unsigned voff = (unsigned)((lane >> 4) * NIN + (lane & 15) * 8) * 2u;
    LAS unsigned char* kl = vl + 32 * VROWB;
    const LAS unsigned char* klane = kl + r32 * KROWB + 16 * hi;
    const float bb = -c2 * (float)(qpos - 4 * hi);
#define B0(r) (bb + c2 * (float)(((r) & 3) + 8 * ((r) >> 2)))
    float m0 = NEGBIG, l0 = 0.f, m1 = NEGBIG, l1 = 0.f;
    bf16x8 kf[8]; u32x4 kr[8];
    float sh = 0.f;
    {
        u32x4 krb[8];
        const LAS unsigned char* klaneB = vl + r32 * VROWB + 16 * hi;
        load_v(kr, kcol, 1, voff);
        load_v(krb, kcol + (size_t)((qb >= 1 ? 1 : 0) * 32) * NIN, 1, voff);
        store_k(kl, kr, lane); store_v(vl, krb, lane);
#define DIFF_STATS(S0, S1, KC) do { \
            _Pragma("unroll") for (int r = 0; r < 16; ++r) { const float bq = B0(r); S0[r] = S0[r] * c1 + bq; S1[r] = S1[r] * c1 + bq; } \
            if ((KC) == qb) { _Pragma("unroll") for (int r = 0; r < 16; ++r) if (crow(r, hi) > r32) { S0[r] = NEGBIG; S1[r] = NEGBIG; } } \
            float cm0 = S0[0], cm1 = S1[0]; \
            _Pragma("unroll") for (int r = 1; r < 16; ++r) { cm0 = fmaxf(cm0, S0[r]); cm1 = fmaxf(cm1, S1[r]); } \
            const float shk = c2s * (float)(KC); \
            const float n0 = fmaxf(m0, cm0 + shk), n1 = fmaxf(m1, cm1 + shk), e0 = n0 - shk, e1 = n1 - shk; \
            float a0 = 0.f, a1 = 0.f; \
            _Pragma("unroll") for (int r = 0; r < 16; ++r) { a0 += __builtin_amdgcn_exp2f(S0[r] - e0); a1 += __builtin_amdgcn_exp2f(S1[r] - e1); } \
            l0 = l0 * __builtin_amdgcn_exp2f(m0 - n0) + a0; l1 = l1 * __builtin_amdgcn_exp2f(m1 - n1) + a1; m0 = n0; m1 = n1; } while (0)
#pragma unroll 1
        for (int kc = 0; kc <= qb; kc += 2) {
            f32x16 sa0 = {}, sa1 = {}, sb0 = {}, sb1 = {};
            read_kf(kf, klane);
#pragma unroll
            for (int d0 = 0; d0 < 4; ++d0) { sa0 = MFMA32(kf[d0], qf[d0], sa0); sa1 = MFMA32(kf[4 + d0], qf[4 + d0], sa1); }
            read_kf(kf, klaneB);
#pragma unroll
            for (int d0 = 0; d0 < 4; ++d0) { sb0 = MFMA32(kf[d0], qf[d0], sb0); sb1 = MFMA32(kf[4 + d0], qf[4 + d0], sb1); }
            const int ka = kc + 2 <= qb ? kc + 2 : qb, kb2 = kc + 3 <= qb ? kc + 3 : qb;
            load_v(kr, kcol + (size_t)(ka * 32) * NIN, 1, voff);
            DIFF_STATS(sa0, sa1, kc);
            asm volatile("" : "+v"(m0), "+v"(l0), "+v"(m1), "+v"(l1));
            load_v(krb, kcol + (size_t)(kb2 * 32) * NIN, 1, voff);
            if (kc + 1 <= qb) DIFF_STATS(sb0, sb1, kc + 1);
            store_k(kl, kr, lane); store_v(vl, krb, lane);
        }
#undef DIFF_STATS
    }
    { const float mo0 = sx(m0, 32, lane), lo0 = sx(l0, 32, lane), mo1 = sx(m1, 32, lane), lo1 = sx(l1, 32, lane);
      const float M0 = fmaxf(m0, mo0), M1 = fmaxf(m1, mo1);
      l0 = l0 * __builtin_amdgcn_exp2f(m0 - M0) + lo0 * __builtin_amdgcn_exp2f(mo0 - M0); l1 = l1 * __builtin_amdgcn_exp2f(m1 - M1) + lo1 * __builtin_amdgcn_exp2f(mo1 - M1); m0 = M0; m1 = M1; }
    const float i0 = 1.0f / l0, i1 = lam / l1;
    f32x16 ot[4];
#pragma unroll
    for (int db = 0; db < 4; ++db) ot[db] = (f32x16){};
    const int g = lane >> 4, ii = lane & 15;
    const LAS unsigned char* vtb = vl + (4 * (g >> 1) + (ii >> 2)) * VROWB + (16 * (g & 1) + 4 * (ii & 3)) * 2;
    u32x4 vr[8];
    load_v(vr, vcol, 1, voff);
    load_v(kr, kcol, 1, voff);
    store_v(vl, vr, lane);
    store_k(kl, kr, lane);
    sh = 0.f;
#pragma unroll 1
    for (int kc = 0; kc <= qb; ++kc) {
        read_kf(kf, klane);
        f32x16 s0 = {}, s1 = {};
#pragma unroll
        for (int d0 = 0; d0 < 4; ++d0) { s0 = MFMA32(kf[d0], qf[d0], s0); s1 = MFMA32(kf[4 + d0], qf[4 + d0], s1); }
        const int kn = kc < qb ? kc + 1 : kc;
        load_v(kr, kcol + (size_t)(kn * 32) * NIN, 1, voff);
        if (kc == qb) {
#pragma unroll
            for (int r = 0; r < 16; ++r) if (crow(r, hi) > r32) { s0[r] = NEGBIG; s1[r] = NEGBIG; }
        }
        const float e0 = m0 - sh, e1 = m1 - sh;
        float p[16];
#pragma unroll
        for (int r = 0; r < 16; ++r) { const float bq0 = B0(r) - e0, bq1 = B0(r) - e1; p[r] = __builtin_amdgcn_exp2f(s0[r] * c1 + bq0) * i0 - __builtin_amdgcn_exp2f(s1[r] * c1 + bq1) * i1; }
        bf16x8 pf0 = pack8(p), pf1 = pack8(p + 8);
        asm volatile("" : "+v"(pf0), "+v"(pf1));
        load_v(vr, vcol + (size_t)(kn * 32) * NIN, 1, voff);
        pv_chunk(ot, vtb, pf0, pf1);
        store_k(kl, kr, lane);
        store_v(vl, vr, lane);
        sh += c2s;
    }
    float ss = 0.f;
#pragma unroll
    for (int db = 0; db < 4; ++db)
#pragma unroll
        for (int r = 0; r < 16; ++r) ss += ot[db][r] * ot[db][r];
    ss += sx(ss, 32, lane);
    const float rn = (1.0f / sqrtf(ss * (1.f / 128.f) + RMS_EPS)) * post;
    bf16_t* op = xo + (rowb + qpos) * DM + h * 128;
    u32x2 o2[16];
#pragma unroll
    for (int db = 0; db < 4; ++db)
#pragma unroll
        for (int rg = 0; rg < 4; ++rg) { const int d = 32 * db + 8 * rg + 4 * hi; const f32x4 gg = *(const f32x4*)(g_diff + d);
            u32x2 w; w.x = pg8::cvt_pk_bf16(ot[db][4 * rg] * rn * gg[0], ot[db][4 * rg + 1] * rn * gg[1]); w.y = pg8::cvt_pk_bf16(ot[db][4 * rg + 2] * rn * gg[2], ot[db][4 * rg + 3] * rn * gg[3]);
            o2[4 * db + rg] = w; }
    store_rows_wide(op, o2, hi);
}
__device__ __forceinline__ void dil_task(const bf16_t* proj, bf16_t* po, int ldo, float* lse, int b, int h, int dil, int c, int pb, int  , LAS unsigned char* vl) {
    int lane; asm volatile("v_mbcnt_lo_u32_b32 %0, -1, 0\n\tv_mbcnt_hi_u32_b32 %0, -1, %0" : "=v"(lane));
    const int r32 = lane & 31, hi = lane >> 5;
    const size_t row0 = (size_t)b * SEQ + c;
    const size_t qrow = row0 + (size_t)(pb * 32 + r32) * dil;
    const float slope = exp2f(-(float)(h + 1));
    const float c1 = 0.08838834764831845f * LOG2E, c2 = slope * LOG2E * (float)dil, c2s = c2 * 32.f;
    bf16x8 qf[8];
    { const bf16_t* qp = proj + qrow * NIN + 3072 + h * 128 + 8 * hi;
#pragma unroll
      for (int d0 = 0; d0 < 8; ++d0) qf[d0] = *(const bf16x8*)(qp + 16 * d0); }
    const bf16_t* kcol = proj + 4096 + h * 128 + row0 * NIN;
    const bf16_t* vcol = proj + 5120 + h * 128 + row0 * NIN;
    const unsigned voff = (unsigned)((lane >> 4) * dil * NIN + (lane & 15) * 8) * 2u;
    const size_t cstep = (size_t)32 * dil;
    const int g = lane >> 4, ii = lane & 15;
    const LAS unsigned char* vtb = vl + (4 * (g >> 1) + (ii >> 2)) * VROWB + (16 * (g & 1) + 4 * (ii & 3)) * 2;
    LAS unsigned char* kl = vl + 32 * VROWB;
    const LAS unsigned char* klane = kl + r32 * KROWB + 16 * hi;
    const float bb = -c2 * (float)(r32 - 4 * hi);
    f32x16 ot[4];
#pragma unroll
    for (int db = 0; db < 4; ++db) ot[db] = (f32x16){};
    float m = NEGBIG, l = 0.f;
    const int kc0 = pb >= 4 ? pb - 4 : 0;
    bf16x8 kf[8]; u32x4 vr[8], kr[8];
    load_v(vr, vcol + kc0 * cstep * NIN, dil, voff);
    load_v(kr, kcol + kc0 * cstep * NIN, dil, voff);
    store_v(vl, vr, lane);
    store_k(kl, kr, lane);
    float sh = -c2s * (float)(pb - kc0);
#pragma unroll 1
    for (int kc = kc0; kc <= pb; ++kc) {
        read_kf(kf, klane);
        f32x16 st = {};
#pragma unroll
        for (int d0 = 0; d0 < 8; ++d0) st = MFMA32(kf[d0], qf[d0], st);
        const int kn = kc < pb ? kc + 1 : kc;
        load_v(kr, kcol + kn * cstep * NIN, dil, voff);
#pragma unroll
        for (int r = 0; r < 16; ++r) st[r] = st[r] * c1 + B0(r);
        if (kc == pb) {
#pragma unroll
            for (int r = 0; r < 16; ++r) if (crow(r, hi) > r32) st[r] = NEGBIG;
        }
        if (kc + 4 == pb) {
#pragma unroll
            for (int r = 0; r < 16; ++r) if (crow(r, hi) < r32) st[r] = NEGBIG;
        }
        float cm = st[0];
#pragma unroll
        for (int r = 1; r < 16; ++r) cm = fmaxf(cm, st[r]);
        cm = fmaxf(cm, sx(cm, 32, lane)) + sh;
        const float mn = fmaxf(m, cm), al = __builtin_amdgcn_exp2f(m - mn), e = mn - sh;
        m = mn; l *= al;
#pragma unroll
        for (int db = 0; db < 4; ++db) ot[db] = ot[db] * al;
        float p[16]; float a = 0.f;
#pragma unroll
        for (int r = 0; r < 16; ++r) { p[r] = __builtin_amdgcn_exp2f(st[r] - e); a += p[r]; }
        l += a;
        bf16x8 pf0 = pack8(p), pf1 = pack8(p + 8);
        asm volatile("" : "+v"(pf0), "+v"(pf1));
        load_v(vr, vcol + kn * cstep * NIN, dil, voff);
        pv_chunk(ot, vtb, pf0, pf1);
        store_k(kl, kr, lane);
        store_v(vl, vr, lane);
        sh += c2s;
    }
    l += sx(l, 32, lane);
    const float inv = 1.0f / l;
    bf16_t* op = po + qrow * ldo + h * 128;
    { u32x2 o2[16];
#pragma unroll
      for (int db = 0; db < 4; ++db)
#pragma unroll
          for (int rg = 0; rg < 4; ++rg) { u32x2 w; w.x = pg8::cvt_pk_bf16(ot[db][4 * rg] * inv, ot[db][4 * rg + 1] * inv); w.y = pg8::cvt_pk_bf16(ot[db][4 * rg + 2] * inv, ot[db][4 * rg + 3] * inv); o2[4 * db + rg] = w; }
      store_rows_wide(op, o2, hi); }
    if (hi == 0) lse[qrow * 8 + h] = m + __builtin_amdgcn_logf(l);
}
__device__ __forceinline__ void dil_combine_load(float (&o)[16], float& rn, const bf16_t* p0, const bf16_t* p1, const bf16_t* xo, const float* lse0, const float* lse1, const float* lse2, int lane) {
    const int h = lane >> 3, seg = lane & 7;
    const float e0 = lse0[h], e1 = lse1[h], e2 = lse2[h], em = fmaxf(e0, fmaxf(e1, e2));
    float w0 = __builtin_amdgcn_exp2f(e0 - em), w1 = __builtin_amdgcn_exp2f(e1 - em), w2 = __builtin_amdgcn_exp2f(e2 - em); const float wi = 1.0f / (w0 + w1 + w2); w0 *= wi; w1 *= wi; w2 *= wi;
    const int off = h * 128 + seg * 16;
    float ss = 0.f;
#pragma unroll
    for (int j = 0; j < 2; ++j) { const u32x4 a = *(const u32x4*)(p0 + off + 8 * j), bq = *(const u32x4*)(p1 + off + 8 * j), cq = *(const u32x4*)(xo + off + 8 * j);
#pragma unroll
        for (int e = 0; e < 4; ++e) { o[8 * j + 2 * e] = w0 * bflo(a[e]) + w1 * bflo(bq[e]) + w2 * bflo(cq[e]); o[8 * j + 2 * e + 1] = w0 * bfhi(a[e]) + w1 * bfhi(bq[e]) + w2 * bfhi(cq[e]); } }
#pragma unroll
    for (int d = 0; d < 16; ++d) ss += o[d] * o[d];
    ss += sx(ss, 1, lane); ss += sx(ss, 2, lane); ss += sx(ss, 4, lane);
    rn = 1.0f / sqrtf(ss * (1.f / 128.f) + RMS_EPS);
}
__device__ __forceinline__ void dil_combine_store(const float (&o)[16], float rn, bf16_t* xo, const float* g_dil, int lane) {
    const int h = lane >> 3, seg = lane & 7; const int off = h * 128 + seg * 16;
#pragma unroll
    for (int j = 0; j < 2; ++j) { u32x4 w;
#pragma unroll
        for (int e = 0; e < 4; ++e) w[e] = pk2(o[8 * j + 2 * e] * rn * g_dil[seg * 16 + 8 * j + 2 * e], o[8 * j + 2 * e + 1] * rn * g_dil[seg * 16 + 8 * j + 2 * e + 1]);
        *(u32x4*)(xo + off + 8 * j) = w; }
}

#define XB_TMO      128
#define XB_XCNT(j)  (256  + 64 * (j))
#define XB_XSUB(j)  (1280 + 64 * (j))
#define XB_XGEN(j)  (2304 + 64 * (j))
#define XB_TOP      3328
#define XB_TOPGEN   3392
#define XCD_BAR_WORDS 3456
#define XB_SPIN_CAP (1u << 22)

__device__ __forceinline__ unsigned xb_ld(unsigned* p)              { return __hip_atomic_load(p, __ATOMIC_RELAXED, __HIP_MEMORY_SCOPE_AGENT); }
__device__ __forceinline__ unsigned xb_add(unsigned* p, unsigned v) { return __hip_atomic_fetch_add(p, v, __ATOMIC_RELAXED, __HIP_MEMORY_SCOPE_AGENT); }
__device__ __forceinline__ unsigned xb_xcc_id() { return (unsigned)__builtin_amdgcn_s_getreg((3 << 11) | 20) & 0xFu; }
#define XB_SPIN(cond, bar) do { unsigned _sp = 0; while (cond) { __builtin_amdgcn_s_sleep(1); \
    if ((++_sp & 255u) == 0u) { if (xb_ld(&(bar)[XB_TMO])) break; if (_sp > XB_SPIN_CAP) { atomicAdd(&(bar)[XB_TMO], 1u); break; } } } } while (0)

struct XcdBarrier {
    unsigned* bar; unsigned x;
    volatile LAS unsigned* st;
};

__device__ __forceinline__ XcdBarrier xcd_barrier_post(unsigned* bar, volatile LAS unsigned* st) {
    XcdBarrier b; b.bar = bar; b.x = xb_xcc_id(); b.st = st;
    if (threadIdx.x == 0) (void)xb_add(&bar[XB_XCNT(b.x)], 1u);
    return b;
}
__device__ __forceinline__ void xcd_barrier_complete(unsigned* bar, unsigned x, unsigned& nloc, unsigned& nx) {
    const unsigned G = gridDim.x * gridDim.y * gridDim.z;
    unsigned sum, cnt, mine, sp = 0u;
    for (;;) {
        sum = 0u; cnt = 0u; mine = 0u;
#pragma unroll
        for (unsigned j = 0; j < 16; ++j) { const unsigned c = xb_ld(&bar[XB_XCNT(j)]); sum += c; cnt += (c > 0u) ? 1u : 0u; mine = (j == x) ? c : mine; }
        if (sum == G) break;
        __builtin_amdgcn_s_sleep(1);
        if ((++sp & 255u) == 0u) { if (xb_ld(&bar[XB_TMO])) break; if (sp > XB_SPIN_CAP) { atomicAdd(&bar[XB_TMO], 1u); break; } }
    }
    nloc = mine > 0u ? mine : 1u; nx = cnt > 0u ? cnt : 1u;
}

__device__ __forceinline__ void xcd_barrier(const XcdBarrier& b) {
    asm volatile("s_waitcnt vmcnt(0)" ::: "memory");
    __syncthreads();
    if (threadIdx.x == 0) {
        unsigned* bar = b.bar;
        __builtin_amdgcn_s_waitcnt(0);
        unsigned nloc = b.st[0], nx = b.st[1];
        if (nloc == 0u) { xcd_barrier_complete(bar, b.x, nloc, nx); b.st[0] = nloc; b.st[1] = nx; }
        const unsigned old = xb_add(&bar[XB_XSUB(b.x)], 1u);
        const unsigned gen = old / nloc;
        if (old + 1u == (gen + 1u) * nloc) {
            __builtin_amdgcn_fence(__ATOMIC_RELEASE, "agent");
            asm volatile("s_waitcnt vmcnt(0)" ::: "memory");
            const unsigned og = xb_add(&bar[XB_TOP], 1u);
            const unsigned tg = og / nx;
            if (og + 1u == (tg + 1u) * nx) xb_add(&bar[XB_TOPGEN], 1u);
            else XB_SPIN(xb_ld(&bar[XB_TOPGEN]) == tg, bar);
            __builtin_amdgcn_fence(__ATOMIC_ACQUIRE, "agent");
            xb_add(&bar[XB_XGEN(b.x)], 1u);
            asm volatile("s_waitcnt vmcnt(0)" ::: "memory");
        } else {
            XB_SPIN(xb_ld(&bar[XB_XGEN(b.x)]) == gen, bar);
            __builtin_amdgcn_fence(__ATOMIC_ACQUIRE, "agent");
            asm volatile("s_waitcnt vmcnt(0)" ::: "memory");
        }
    }
    __syncthreads();
}

constexpr int NWAVES = 8;
constexpr int GRID_BLOCKS = 256;
constexpr int LDS_BYTES = 155648;

__global__ void __launch_bounds__(NWAVES * 64, 2) mega_fwd(Params P) {
    extern __shared__ __attribute__((aligned(16))) unsigned char lds_raw[];
    LAS unsigned char* lds = (LAS unsigned char*)lds_raw;
    cg::grid_group grid = cg::this_grid();
    const int wave = __builtin_amdgcn_readfirstlane((int)threadIdx.x >> 6);
    constexpr int G = GRID_BLOCKS; const int bx = blockIdx.x;
    const int gw = bx * NWAVES + wave, NGW = G * NWAVES;
    const int NGT = G * NWAVES * 64;
#define PH_IDS int lane_; asm volatile("v_mbcnt_lo_u32_b32 %0, -1, 0\n\tv_mbcnt_hi_u32_b32 %0, -1, %0" : "=v"(lane_)); const int lane = lane_; const int tid_ = wave * 64 + lane_; const int gt = bx * (NWAVES * 64) + tid_; (void)lane; (void)gt; (void)tid_;
    unsigned char* ws = P.ws;
    const float* x = P.in[0]; const float* mem = P.in[1];
    bf16_t* Wl = (bf16_t*)(ws + WS_W);
    bf16_t* XB = (bf16_t*)(ws + WS_XB); bf16_t* XBB = (bf16_t*)(ws + WS_XBB);
    bf16_t* BIG = (bf16_t*)(ws + WS_BIG);
    bf16_t* MEMB = (bf16_t*)(ws + WS_MEMB); bf16_t* KMEM = (bf16_t*)(ws + WS_KMEM); bf16_t* VT = (bf16_t*)(ws + WS_VT);
    float* RAWH = (float*)(ws + WS_RAWH); float* RAWT = (float*)(ws + WS_RAWT); float* RSUM = (float*)(ws + WS_RSUM);
    float* H = P.out;
    volatile LAS unsigned* bar_st = (volatile LAS unsigned*)(lds + LDS_BYTES - 64);
    if (threadIdx.x < 2) bar_st[threadIdx.x] = 0u;
    __syncthreads();
    XcdBarrier xbar = xcd_barrier_post((unsigned*)ws, bar_st);
#define GRID_SYNC() xcd_barrier(xbar)
    float* IDENT = (float*)(ws + WS_IDENT); float* STATS = (float*)(ws + WS_STATS);
    float* CSF = (float*)(ws + WS_CSF); float* BWF = CSF + NCOLS;
    float* CSP = (float*)(ws + WS_BIG + 64 * MiB);
    bf16_t* WKV = BIG;
    bf16_t* PART0 = (bf16_t*)(ws + WS_RAWH); bf16_t* PART1 = (bf16_t*)(ws + WS_PART1); float* LSE = (float*)(ws + WS_LSE);
#define PSTAT(i) ((float*)(ws + WS_PSTAT + (size_t)(i) * 8 * MiB))

#pragma unroll 1
    for (int l = 0; l < NLAYER; ++l) {
        {
            PH_IDS
            LAS float* scr = (LAS float*)(lds + wave * 17408);
            if (l == 0) {
                for (int i = gt; i < 2 * DM; i += NGT) IDENT[i] = i < DM ? 1.f : 0.f;
                for (size_t i = gt; i < (size_t)TOK * DM / 4; i += (size_t)NGT * 8) { f32x4 v[8];
#pragma unroll
                    for (int j = 0; j < 8; ++j) v[j] = ((const f32x4*)x)[i + (size_t)j * NGT];
#pragma unroll
                    for (int j = 0; j < 8; ++j) { u32x2 w; w.x = pk2(v[j][0], v[j][1]); w.y = pk2(v[j][2], v[j][3]); ((u32x2*)XBB)[i + (size_t)j * NGT] = w; } }
                for (size_t i = gt; i < (size_t)MEMT * DM / 4; i += (size_t)NGT * 8) { f32x4 v[8];
#pragma unroll
                    for (int j = 0; j < 8; ++j) v[j] = ((const f32x4*)mem)[i + (size_t)j * NGT];
#pragma unroll
                    for (int j = 0; j < 8; ++j) { u32x2 w; w.x = pk2(v[j][0], v[j][1]); w.y = pk2(v[j][2], v[j][3]); ((u32x2*)MEMB)[i + (size_t)j * NGT] = w; } }
                for (int i = gt; i < 2 * TOK; i += NGT) STATS[i] = (float)(i & 1);
            }
#pragma unroll 1
            for (int k = 0; k < 8; ++k) {
                if (k >= 6 && l != 0) break;
                const float* src; int K, N, mode = 0; bf16_t* dst; const float* gv = nullptr; const float* bv = nullptr; float* csp = nullptr;
                if (k == 0)      { src = P.in[2]  + (size_t)l * DM * NIN;  K = DM;  N = NIN; dst = Wl + WO_IN;  csp = CSP + (size_t)CB_IN * 2; }
                else if (k == 1) { src = P.in[3]  + (size_t)l * DM * DM;   K = DM;  N = DM;  dst = Wl + WO_OUT; }
                else if (k == 2) { src = P.in[12] + (size_t)l * DM * DM;   K = DM;  N = DM;  dst = Wl + WO_Q;   gv = P.in[10] + l * DM; bv = P.in[11] + l * DM; csp = CSP + (size_t)CB_Q * 2; }
                else if (k == 3) { src = P.in[14] + (size_t)l * DM * DM;   K = DM;  N = DM;  dst = Wl + WO_O; }
                else if (k == 4) { src = P.in[17] + (size_t)l * DM * NUP;  K = DM;  N = NUP; dst = Wl + WO_UP;  mode = 1; gv = P.in[15] + l * DM; bv = P.in[16] + l * DM; csp = CSP + (size_t)CB_UP * 2; }
                else if (k == 5) { src = P.in[20] + (size_t)l * DFF * DM;  K = DFF; N = DM;  dst = Wl + WO_DN; }
                else             { src = P.in[13] + (size_t)(k - 6) * DM * 2 * DM; K = DM; N = 2 * DM; dst = WKV + (size_t)(k - 6) * 2 * DM * DM; }
                if (k == 0 && l != 0) { gv = P.in[21] + (l - 1) * DM; bv = P.in[22] + (l - 1) * DM; }
                const int nblk = N >> 6, nmagic = N == NIN ? 10923 : (N == DM ? 32768 : (N == NUP ? 5958 : 16384));
                const int items = (K >> 6) * nblk;
                for (int it = gw; it < items; it += NGW) transpose_item(src, K, N, dst, mode, scr, it, lane, gv, bv, csp, nblk, nmagic);
            }
        }
        __syncthreads();
        if (l == 0) grid.sync(); else GRID_SYNC();
        {
            PH_IDS
            for (int col = gt; col < NCOLS; col += NGT) { float cs = 0.f, bs = 0.f;
#pragma unroll 8
                for (int kb = 0; kb < 32; ++kb) { const f32x2 v = *(const f32x2*)(CSP + ((size_t)kb * NCOLS + col) * 2); cs += v[0]; bs += v[1]; }
                CSF[col] = cs; BWF[col] = bs; }
        }
        if (l == 0) {
            pg8::Gemm g{(const bf16_t*)ws, (const bf16_t*)ws, DM, DM, DM};
            pg8::SchedKV S{G, ((bx & 7) * (G / 8)) + (bx >> 3), (long)WS_MEMB, (long)WS_BIG, (long)(WS_BIG + (size_t)2 * DM * DM * 2)};
            pg8::EpiBf16Sel E{KMEM, VT, (bf16_t*)(ws + WS_KV1), (bf16_t*)(ws + WS_KV1 + 16 * MiB)};
            pg8::gemm_phase(lds, g, S, E, wave);
        }
        __syncthreads();
        GRID_SYNC();

        const bf16_t* KMl = l == 0 ? KMEM : (const bf16_t*)(ws + WS_KV1); const bf16_t* VTl = l == 0 ? VT : (const bf16_t*)(ws + WS_KV1 + 16 * MiB);
        const float lam_init = 0.8f - 0.6f * __expf(-0.3f * (float)l);
        {
            pg8::Gemm g{XBB, Wl + WO_IN, DM, DM, DM}; pg8::Sched2D S; S.init(TOK, NIN, DM, DM, G, bx);
            pg8::EpiBf16A E{BIG, NIN, STATS, CSF + CB_IN, BWF + CB_IN};
            pg8::gemm_phase(lds, g, S, E, wave);
        }
        GRID_SYNC();
        {
            PH_IDS
            const float a1 = wave_sum(P.in[4][l * 64 + lane] * P.in[5][l * 64 + lane], lane);
            const float a2 = wave_sum(P.in[6][l * 64 + lane] * P.in[7][l * 64 + lane], lane);
            const float lam = __int_as_float(__builtin_amdgcn_readfirstlane(__float_as_int(__expf(a1) - __expf(a2) + lam_init)));
            const float* gdf = P.in[8] + l * 128;
            LAS unsigned char* vl = lds + wave * WAVE_LDS;
            const int vgw = (((bx & 7) * (G / 8)) + (bx >> 3)) * NWAVES + wave;
            for (int task = vgw; task < NB * 8 * 32; task += NGW) {
                const int bh = task >> 5, pp = task & 31;
                diff_task(BIG, XB, bh >> 3, bh & 7, pp, lam, 1.f - lam_init, gdf, lane, vl);
                diff_task(BIG, XB, bh >> 3, bh & 7, 63 - pp, lam, 1.f - lam_init, gdf, lane, vl);
            }
            for (int task = vgw; task < 3 * NB * 8 * 64; task += NGW) {
                const int br = task / (NB * 8 * 64), rem = task % (NB * 8 * 64), bh = rem >> 6;
                const int idx = ((rem & 63) + 16 * ((rem >> 11) & 3)) & 63;
                const int dil = br == 0 ? 1 : (br == 1 ? 4 : 16);
                const int c = idx & (dil - 1), pb = idx / dil;
                bf16_t* po = br == 0 ? PART0 : (br == 1 ? PART1 : XB + 1024);
                dil_task(BIG, po, br == 2 ? DM : 1024, LSE + (size_t)br * TOK * 8, bh >> 3, bh & 7, dil, c, pb, lane, vl);
            }
        }
        __syncthreads();
        GRID_SYNC();
        { PH_IDS
          const float* gdl = P.in[9] + l * 128;
          for (int m = gw; m < TOK; m += 4 * NGW) { float o[4][16], rn[4];
#pragma unroll
              for (int j = 0; j < 4; ++j) { const int mm = m + j * NGW; dil_combine_load(o[j], rn[j], PART0 + (size_t)mm * 1024, PART1 + (size_t)mm * 1024, XB + (size_t)mm * DM + 1024, LSE + (size_t)mm * 8, LSE + (size_t)(TOK + mm) * 8, LSE + (size_t)(2 * TOK + mm) * 8, lane); }
#pragma unroll
              for (int j = 0; j < 4; ++j) { const int mm = m + j * NGW; dil_combine_store(o[j], rn[j], XB + (size_t)mm * DM + 1024, gdl, lane); } } }
        __syncthreads();
        GRID_SYNC();
        {
            pg8::Gemm g{XB, Wl + WO_OUT, DM, DM, DM}; pg8::Sched2D S; S.init(TOK, DM, DM, DM, G, bx);
            pg8::EpiResid<false> E{H, XBB, STATS, PSTAT(0), l == 0 ? IDENT : P.in[21] + (l - 1) * DM, l == 0 ? IDENT + DM : P.in[22] + (l - 1) * DM};
            pg8::gemm_phase(lds, g, S, E, wave);
        }
        GRID_SYNC();
        { PH_IDS
          const int fr = lane & 15, fq = lane >> 4; const int row = gw * 16 + fr; float mu, rs;
          pg8::row_stats(PSTAT(0) + (size_t)row * 64, fq, lane, mu, rs);
          if (fq == 0) { f32x2 o2; o2[0] = mu; o2[1] = rs; ((f32x2*)STATS)[row] = o2; } }
        __syncthreads();
        GRID_SYNC();
        bf16_t* QM = BIG; bf16_t* PM = BIG + (size_t)TOK * DM;
        {
            pg8::Gemm g{XBB, Wl + WO_Q, DM, DM, DM}; pg8::Sched2D S; S.init(TOK, DM, DM, DM, G, bx);
            pg8::EpiBf16A E{QM, DM, STATS, CSF + CB_Q, BWF + CB_Q};
            pg8::gemm_phase(lds, g, S, E, wave);
        }
        GRID_SYNC();
        {
            pg8::Gemm g{QM, KMl, DM, DM, 512}; pg8::SchedScores S{G, ((bx & 7) * (G / 8)) + (bx >> 3)};
            pg8::EpiExp E{PM, RSUM, 0.04419417382415922f};
            pg8::gemm_phase(lds, g, S, E, wave);
        }
        GRID_SYNC();
        {
            pg8::Gemm g{PM, VTl, 1024, MEMT, 256}; pg8::SchedPV S{G, ((bx & 7) * (G / 8)) + (bx >> 3)};
            pg8::EpiDivRow E{XB, RSUM};
            pg8::gemm_phase(lds, g, S, E, wave);
        }
        GRID_SYNC();
        {
            pg8::Gemm g{XB, Wl + WO_O, DM, DM, DM}; pg8::Sched2D S; S.init(TOK, DM, DM, DM, G, bx);
            pg8::EpiResid<false> E{H, XBB, STATS, PSTAT(0), P.in[10] + l * DM, P.in[11] + l * DM};
            pg8::gemm_phase(lds, g, S, E, wave);
        }
        GRID_SYNC();
        { PH_IDS
          const int fr = lane & 15, fq = lane >> 4; const int row = gw * 16 + fr; float mu, rs;
          pg8::row_stats(PSTAT(0) + (size_t)row * 64, fq, lane, mu, rs);
          if (fq == 0) { f32x2 o2; o2[0] = mu; o2[1] = rs; ((f32x2*)STATS)[row] = o2; } }
        __syncthreads();
        GRID_SYNC();
        const float* cw = P.in[18] + (size_t)l * 3 * NUP; const float* cb = P.in[19] + (size_t)l * NUP;
        {
            pg8::Gemm g{XBB, Wl + WO_UP, DM, DM, DM}; pg8::Sched2D S; S.init(TOK, NUP, DM, DM, G, bx);
            pg8::EpiConvGate E{BIG, RAWH, RAWT, cw, cb, STATS, CSF + CB_UP, BWF + CB_UP};
            pg8::gemm_phase(lds, g, S, E, wave);
        }
        GRID_SYNC();
        { PH_IDS
        for (int idx = gt; idx < 512 * 2 * (DFF / 4); idx += NGT) {
            const int c4 = idx % (DFF / 4), r = (idx / (DFF / 4)) & 1, run = idx / (2 * (DFF / 4)), ch = c4 * 4;
            const bool first = (run % 32) == 0;
            f32x4 cv[2];
#pragma unroll
            for (int bj = 0; bj < 2; ++bj) {
                const f32x4 z = (f32x4){0.f, 0.f, 0.f, 0.f};
                const f32x4 h0 = *(const f32x4*)(RAWH + ((size_t)(run * 2 + r) * 2 + bj) * DFF + ch);
                const f32x4 t1 = first ? z : *(const f32x4*)(RAWT + ((size_t)((run - 1) * 2 + 1) * 2 + bj) * DFF + ch);
                const f32x4 t0 = first ? z : *(const f32x4*)(RAWT + ((size_t)((run - 1) * 2 + 0) * 2 + bj) * DFF + ch);
                const f32x4 hh0 = *(const f32x4*)(RAWH + ((size_t)(run * 2 + 0) * 2 + bj) * DFF + ch);
                const f32x4 h1 = (r == 1) ? hh0 : t1, h2 = (r == 1) ? t1 : t0;
                const int cidx = bj * DFF + ch;
                const f32x4 w0 = *(const f32x4*)(cw + cidx), w1 = *(const f32x4*)(cw + NUP + cidx), w2 = *(const f32x4*)(cw + 2 * NUP + cidx), bb = *(const f32x4*)(cb + cidx);
                cv[bj] = w2 * h0 + w1 * h1 + w0 * h2 + bb;
            }
            f32x4 o;
#pragma unroll
            for (int e = 0; e < 4; ++e) o[e] = cv[0][e] / (1.0f + __expf(-cv[0][e])) * cv[1][e];
            u32x2 w; w.x = pk2(o[0], o[1]); w.y = pk2(o[2], o[3]);
            *(u32x2*)(BIG + (size_t)(run * 64 + r) * DFF + ch) = w;
        } }
        __syncthreads();
        GRID_SYNC();
        if (l < NLAYER - 1) {
            pg8::Gemm g{BIG, Wl + WO_DN, DFF, DFF, DFF}; pg8::Sched2D S; S.init(TOK, DM, DFF, DFF, G, bx);
            pg8::EpiResid<false> E{H, XBB, STATS, PSTAT(0), P.in[15] + l * DM, P.in[16] + l * DM};
            pg8::gemm_phase(lds, g, S, E, wave);
        } else {
            pg8::Gemm g{BIG, Wl + WO_DN, DFF, DFF, DFF}; pg8::Sched2D S; S.init(TOK, DM, DFF, DFF, G, bx);
            pg8::EpiResid<true> E{H, XBB, STATS, PSTAT(0), P.in[15] + l * DM, P.in[16] + l * DM};
            pg8::gemm_phase(lds, g, S, E, wave);
        }
        GRID_SYNC();
        if (l < NLAYER - 1) {
        { PH_IDS
          const int fr = lane & 15, fq = lane >> 4; const int row = gw * 16 + fr; float mu, rs;
          pg8::row_stats(PSTAT(0) + (size_t)row * 64, fq, lane, mu, rs);
          if (fq == 0) { f32x2 o2; o2[0] = mu; o2[1] = rs; ((f32x2*)STATS)[row] = o2; } }
        __syncthreads();
        GRID_SYNC();
        }
    }
    { PH_IDS
      for (int m = gw; m < TOK; m += NGW) ln_row(H + (size_t)m * DM, H + (size_t)m * DM, (bf16_t*)nullptr, P.in[21] + (NLAYER - 1) * DM, P.in[22] + (NLAYER - 1) * DM, lane); }
}

extern "C" void kernel_launch(void* const* d_in, const int* in_sizes, int n_in, void* d_out, int out_size, void* d_ws, size_t ws_size, hipStream_t stream) {
    static int grid = 0;
    if (grid == 0) {
        if (n_in != 23 || out_size != TOK * DM || ws_size < WS_END) { fprintf(stderr, "kernel_launch: unexpected problem (n_in %d, out %d, ws %zu)\n", n_in, out_size, ws_size); grid = -1; return; }
        int dev = 0, cus = 0, per_cu = 0;
        (void)hipGetDevice(&dev);
        (void)hipDeviceGetAttribute(&cus, hipDeviceAttributeMultiprocessorCount, dev);
        if (hipFuncSetAttribute((const void*)mega_fwd, hipFuncAttributeMaxDynamicSharedMemorySize, LDS_BYTES) != hipSuccess) { fprintf(stderr, "kernel_launch: hipFuncSetAttribute failed\n"); grid = -1; return; }
        if (hipOccupancyMaxActiveBlocksPerMultiprocessor(&per_cu, (const void*)mega_fwd, NWAVES * 64, LDS_BYTES) != hipSuccess || per_cu < 1) { fprintf(stderr, "kernel_launch: occupancy query says %d\n", per_cu); per_cu = 1; }
        (void)hipGetLastError();
        if (cus < GRID_BLOCKS) { fprintf(stderr, "kernel_launch: built for a %d-CU device, found %d\n", GRID_BLOCKS, cus); grid = -1; return; }
        grid = GRID_BLOCKS;
        fprintf(stderr, "kernel_launch: grid %d (cus %d, per_cu %d)\n", grid, cus, per_cu);
    }
    if (grid < 0) return;
    if (hipMemsetAsync(d_ws, 0, 65536, stream) != hipSuccess) { fprintf(stderr, "kernel_launch: hipMemsetAsync failed\n"); return; }
    Params p{};
    for (int i = 0; i < 23; ++i) p.in[i] = (const float*)d_in[i];
    p.out = (float*)d_out; p.ws = (unsigned char*)d_ws;
    void* args[] = {&p};
    hipError_t e = hipLaunchCooperativeKernel((const void*)mega_fwd, dim3(grid), dim3(NWAVES * 64), args, LDS_BYTES, stream);
    if (e != hipSuccess) fprintf(stderr, "kernel_launch: cooperative launch failed: %s (grid %d)\n", hipGetErrorString(e), grid);
}
```

```cpp
#include <hip/hip_runtime.h>
#include <hip/hip_cooperative_groups.h>
#include <cstdio>
#include <cstdint>
namespace cg = cooperative_groups;

#define LAS __attribute__((address_space(3)))
typedef unsigned short bf16_t;
typedef short bf16x8 __attribute__((ext_vector_type(8)));
typedef float f32x4 __attribute__((ext_vector_type(4)));
typedef float f32x2 __attribute__((ext_vector_type(2)));
typedef unsigned u32x4 __attribute__((ext_vector_type(4)));
typedef unsigned u32x2 __attribute__((ext_vector_type(2)));

constexpr int DM = 2048, NB = 16, SEQ = 2048, TOK = NB * SEQ, NIN = 6144, DFF = 5632, NUP = 2 * DFF, MEML = 256, MEMT = NB * MEML;
constexpr int NLAYER = 2;
constexpr float ALPHA_RES = 1.4142135623730951f;
constexpr float LN_EPS = 1e-5f, RMS_EPS = 1e-5f;
constexpr size_t WO_IN = 0, WO_OUT = WO_IN + (size_t)NIN * DM, WO_Q = WO_OUT + (size_t)DM * DM, WO_O = WO_Q + (size_t)DM * DM,
                 WO_UP = WO_O + (size_t)DM * DM, WO_DN = WO_UP + (size_t)NUP * DM, W_LAYER = WO_DN + (size_t)DM * DFF;
constexpr int NCOLS = NIN + DM + NUP, CB_IN = 0, CB_Q = NIN, CB_UP = NIN + DM;
constexpr size_t MiB = 1u << 20;
constexpr size_t WS_CSF = 65536;
constexpr size_t WS_W = 1 * MiB;
constexpr size_t WS_PSTAT = 115 * MiB;
constexpr size_t WS_STATS = 132 * MiB;
constexpr size_t WS_IDENT = 131 * MiB;
constexpr size_t WS_XBB = 136 * MiB;
constexpr size_t WS_XB = 264 * MiB;
constexpr size_t WS_BIG = 392 * MiB;
constexpr size_t WS_MEMB = 776 * MiB, WS_KMEM = 792 * MiB, WS_VT = 808 * MiB;
constexpr size_t WS_RAWH = 824 * MiB, WS_RAWT = 872 * MiB;
constexpr size_t WS_RSUM = 920 * MiB;
constexpr size_t WS_PART1 = 924 * MiB;
constexpr size_t WS_LSE = 988 * MiB;
constexpr size_t WS_KV1 = 992 * MiB;
constexpr size_t WS_END = 1024 * MiB;
#ifndef PROBE_DUP_PRO
#define PROBE_DUP_PRO 0
#endif
#ifndef PROBE_DUP_LN
#define PROBE_DUP_LN 0
#endif
#ifndef PROBE_DUP_UP
#define PROBE_DUP_UP 0
#endif
#ifndef PROBE_SYNCS
#define PROBE_SYNCS 0
#endif
#ifndef PROBE_DUP_ATTN
#define PROBE_DUP_ATTN 0
#endif
#ifndef PROBE_DUP_INPROJ
#define PROBE_DUP_INPROJ 0
#endif
#ifndef ATTN_DIFF_MFMA
#define ATTN_DIFF_MFMA 1
#endif
#ifndef ATTN_DIL_MFMA
#define ATTN_DIL_MFMA 1
#endif

__device__ __forceinline__ float sx(float v, int mask, int lane) { return __int_as_float(__builtin_amdgcn_ds_bpermute((lane ^ mask) << 2, __float_as_int(v))); }
__device__ __forceinline__ float bflo(unsigned w) { return __uint_as_float(w << 16); }
__device__ __forceinline__ float bfhi(unsigned w) { return __uint_as_float(w & 0xffff0000u); }
namespace pg8 {
constexpr int BM = 256, BK = 64, HALF = 128, HTB = HALF * BK * 2, STAGE_BYTES = 8 * HTB, NXCD = 8, WGM = 8;
__host__ __device__ __forceinline__ int lds_byte(int r, int c) { const int st = (r >> 4) * 2 + (c >> 5), rr = r & 15, cc = c & 31, ob = rr * 64 + cc * 2; return st * 1024 + (ob ^ (((ob >> 9) & 1) << 5)); }
__host__ __device__ __forceinline__ void stage_rc(int b, int& R, int& C) { const int st = b / 1024, sb = b % 1024, swz = sb ^ (((sb >> 9) & 1) << 5); R = (st >> 1) * 16 + swz / 64; C = (st & 1) * 32 + (swz % 64) / 2; }
__host__ __device__ __forceinline__ int perm32(int rho) { const int n = rho >> 4, i = rho & 15; return 8 * (i >> 2) + 4 * n + (i & 3); }

struct Unit { int orow, ocol, aux, pad; long a_off, b_off; };
struct Gemm { const bf16_t* A; const bf16_t* Bt; int lda, ldb, K; };

struct Sched2D {
    int nM, nN, nwg, G, c; long aT, bT;
    __device__ void init(int M, int N, int lda, int ldb, int G_, int c_) { nM = M / BM; nN = N / BM; nwg = nM * nN; G = G_; c = c_; aT = (long)BM * lda * 2; bT = (long)BM * ldb * 2; }
    __device__ bool next(int i, Unit& u) const {
        const long L = (long)i * G + c; if (L >= nwg) return false;
        int wgid = (int)L; { const int q = nwg / NXCD, r = nwg % NXCD, xcd = wgid % NXCD, off = wgid / NXCD; wgid = (xcd < r ? xcd * (q + 1) : r * (q + 1) + (xcd - r) * q) + off; }
        const int nig = WGM * nN, gid = wgid / nig, fm = gid * WGM, gsz = (nM - fm) < WGM ? (nM - fm) : WGM;
        const int pm = fm + ((wgid % nig) % gsz), pn = (wgid % nig) / gsz;
        u.orow = pm * BM; u.ocol = pn * BM; u.aux = 0; u.pad = 0; u.a_off = pm * aT; u.b_off = pn * bT; return true;
    }
};
struct SchedKV {
    int G, c; long memb_off, wkv0, wkv1;
    __device__ bool next(int i, Unit& u) const {
        const long L = (long)i * G + c; if (L >= 512) return false;
        const int which = (int)L >> 7, t = (int)L & 127; const long wkv = (which >> 1) ? wkv1 : wkv0; u.aux = which; u.pad = 0;
        if ((which & 1) == 0) { const int pm = t & 15, pn = t >> 4; u.orow = pm * BM; u.ocol = pn * BM; u.a_off = memb_off + (long)pm * BM * DM * 2; u.b_off = wkv + (long)pn * BM * DM * 2; }
        else { const int pm = t & 7, pn = t >> 3; u.orow = pm * BM; u.ocol = pn * BM; u.a_off = wkv + (long)(DM + pm * BM) * DM * 2; u.b_off = memb_off + (long)pn * BM * DM * 2; }
        return true;
    }
};
struct SchedScores {
    int G, c;
    __device__ bool next(int i, Unit& u) const {
        const long L = (long)i * G + c; if (L >= NB * 4 * 8) return false;
        const int b = (int)L / 32, h = ((int)L / 8) % 4, qt = (int)L % 8;
        u.orow = b * SEQ + qt * 256; u.ocol = h * 256; u.aux = h; u.pad = 0;
        u.a_off = ((long)u.orow * DM + h * 512) * 2; u.b_off = ((long)(b * MEML) * DM + h * 512) * 2; return true;
    }
};
struct SchedPV {
    int G, c;
    __device__ bool next(int i, Unit& u) const {
        const long L = (long)i * G + c; if (L >= NB * 4 * 8 * 2) return false;
        const int b = (int)L / 64, h = ((int)L / 16) % 4, qt = ((int)L / 2) % 8, dt = (int)L % 2;
        u.orow = b * SEQ + qt * 256; u.ocol = h * 512 + dt * 256; u.aux = h; u.pad = 0;
        u.a_off = ((long)u.orow * 1024 + h * 256) * 2; u.b_off = ((long)(h * 512 + dt * 256) * MEMT + b * MEML) * 2; return true;
    }
};

__device__ __forceinline__ unsigned cvt_pk_bf16(float lo, float hi) { unsigned r; asm volatile("v_cvt_pk_bf16_f32 %0, %1, %2" : "=v"(r) : "v"(lo), "v"(hi)); return r; }

struct EpiBf16 {
    static constexpr bool PERM = true;
    bf16_t* O; int ldc; float sc;
    __device__ __forceinline__ void operator()(f32x4 (&acc)[2][2][4][2], const Unit& u, int wr, int wc, int fr, int fq) const {
        const int row0 = u.orow + wr * 64 + fr, col0 = u.ocol + wc * 32 + 8 * fq;
#pragma unroll
        for (int ai = 0; ai < 2; ++ai)
#pragma unroll
            for (int m = 0; m < 4; ++m) { bf16_t* rowp = O + (size_t)(row0 + ai * HALF + m * 16) * ldc + col0;
#pragma unroll
                for (int bj = 0; bj < 2; ++bj) { const f32x4 v0 = acc[ai][bj][m][0] * sc, v1 = acc[ai][bj][m][1] * sc;
                    u32x4 w; w.x = cvt_pk_bf16(v0[0], v0[1]); w.y = cvt_pk_bf16(v0[2], v0[3]); w.z = cvt_pk_bf16(v1[0], v1[1]); w.w = cvt_pk_bf16(v1[2], v1[3]);
                    *(u32x4*)(rowp + bj * HALF) = w; } }
    }
};
__device__ __forceinline__ void row_stats(const float* ps, int fq, int lane, float& mu, float& rs) {
    const f32x4* p = (const f32x4*)(ps + fq * 16);
    const f32x4 a = p[0], b = p[1], c = p[2], d = p[3];
    float s = (a[0] + a[2]) + (b[0] + b[2]) + (c[0] + c[2]) + (d[0] + d[2]);
    float q = (a[1] + a[3]) + (b[1] + b[3]) + (c[1] + c[3]) + (d[1] + d[3]);
    s += sx(s, 16, lane); q += sx(q, 16, lane); s += sx(s, 32, lane); q += sx(q, 32, lane);
    mu = s * (1.f / DM); rs = 1.f / sqrtf(q * (1.f / DM) - mu * mu + LN_EPS);
}
template <bool F32OUT>
struct EpiResid {
    static constexpr bool PERM = true;
    float* hout; bf16_t* xb; const float* ps_prev  ; float* ps_new  ; const float* g; const float* b;
    __device__ __forceinline__ void operator()(f32x4 (&acc)[2][2][4][2], const Unit& u, int wr, int wc, int  , int  ) const {
        int lane; asm volatile("v_mbcnt_lo_u32_b32 %0, -1, 0\n\tv_mbcnt_hi_u32_b32 %0, -1, %0" : "=v"(lane));
        const int fr = lane & 15, fq = lane >> 4;
        const int col0 = u.ocol + wc * 32 + 8 * fq, slot = (u.ocol >> 8) * 4 + wc;
        const int rowb = u.orow + wr * 64 + fr;
        float mu[8], rs[8];
#pragma unroll
        for (int it = 0; it < 8; ++it) { const f32x2 st = *(const f32x2*)(ps_prev + (size_t)(rowb + (it >> 2) * HALF + (it & 3) * 16) * 2); mu[it] = st[0]; rs[it] = st[1]; }
        {
            f32x4 gv[2][2], bv[2][2];
#pragma unroll
            for (int bj = 0; bj < 2; ++bj)
#pragma unroll
                for (int n = 0; n < 2; ++n) { gv[bj][n] = *(const f32x4*)(g + col0 + bj * HALF + n * 4) * ALPHA_RES; bv[bj][n] = *(const f32x4*)(b + col0 + bj * HALF + n * 4) * ALPHA_RES; }
            u32x4 hv[2], hn[2];
#pragma unroll
            for (int bj = 0; bj < 2; ++bj) { hv[bj] = *(const u32x4*)(xb + (size_t)rowb * DM + col0 + bj * HALF); hn[bj] = hv[bj]; }
#pragma unroll
            for (int it = 0; it < 8; ++it) {
                const int ai = it >> 2, m = it & 3;
                if (it < 7) { int rown = rowb + ((it + 1) >> 2) * HALF + ((it + 1) & 3) * 16; asm volatile("" : "+v"(rown));
                    const size_t offn = (size_t)rown * DM + col0;
#pragma unroll
                    for (int bj = 0; bj < 2; ++bj) hn[bj] = *(const u32x4*)(xb + offn + bj * HALF); }
                asm volatile("" : "+v"(hv[0]), "+v"(hv[1]));
#pragma unroll
                for (int bj = 0; bj < 2; ++bj) { const f32x4 h0 = (f32x4){bflo(hv[bj].x), bfhi(hv[bj].x), bflo(hv[bj].y), bfhi(hv[bj].y)}, h1 = (f32x4){bflo(hv[bj].z), bfhi(hv[bj].z), bflo(hv[bj].w), bfhi(hv[bj].w)};
                    acc[ai][bj][m][0] = ((h0 - mu[it]) * rs[it]) * gv[bj][0] + bv[bj][0] + acc[ai][bj][m][0];
                    acc[ai][bj][m][1] = ((h1 - mu[it]) * rs[it]) * gv[bj][1] + bv[bj][1] + acc[ai][bj][m][1]; hv[bj] = hn[bj]; }
            }
        }
#pragma unroll
        for (int ai = 0; ai < 2; ++ai)
#pragma unroll
            for (int m = 0; m < 4; ++m) asm volatile("" : "+v"(acc[ai][0][m][0]), "+v"(acc[ai][0][m][1]), "+v"(acc[ai][1][m][0]), "+v"(acc[ai][1][m][1]));
        int rowb2 = rowb; asm volatile("" : "+v"(rowb2));
#pragma unroll
        for (int it = 0; it < 8; ++it) {
            const int ai = it >> 2, m = it & 3; int row = rowb2 + ai * HALF + m * 16; asm volatile("" : "+v"(row)); const size_t off = (size_t)row * DM + col0;
            float s1 = 0.f, s2 = 0.f;
#pragma unroll
            for (int bj = 0; bj < 2; ++bj) { const f32x4 y0 = acc[ai][bj][m][0], y1 = acc[ai][bj][m][1];
                if (F32OUT) { *(f32x4*)(hout + off + bj * HALF) = y0; *(f32x4*)(hout + off + bj * HALF + 4) = y1; }
                else { s1 += ((y0[0] + y0[1]) + (y0[2] + y0[3])) + ((y1[0] + y1[1]) + (y1[2] + y1[3]));
                    s2 += ((y0[0] * y0[0] + y0[1] * y0[1]) + (y0[2] * y0[2] + y0[3] * y0[3])) + ((y1[0] * y1[0] + y1[1] * y1[1]) + (y1[2] * y1[2] + y1[3] * y1[3]));
                    u32x4 w; w.x = cvt_pk_bf16(y0[0], y0[1]); w.y = cvt_pk_bf16(y0[2], y0[3]); w.z = cvt_pk_bf16(y1[0], y1[1]); w.w = cvt_pk_bf16(y1[2], y1[3]); *(u32x4*)(xb + off + bj * HALF) = w; } }
            if (!F32OUT) { s1 += sx(s1, 16, lane); s2 += sx(s2, 16, lane); s1 += sx(s1, 32, lane); s2 += sx(s2, 32, lane);
                if (fq == 0) { f32x2 o2; o2[0] = s1; o2[1] = s2; *(f32x2*)(ps_new + (size_t)row * 64 + slot * 2) = o2; } }
        }
    }
};
struct EpiBf16A {
    static constexpr bool PERM = true;
    bf16_t* O; int ldc; const float* ps; const float* cs; const float* bw;
    __device__ __forceinline__ void operator()(f32x4 (&acc)[2][2][4][2], const Unit& u, int wr, int wc, int fr, int fq) const {
        const int row0 = u.orow + wr * 64 + fr, col0 = u.ocol + wc * 32 + 8 * fq;
        f32x4 cv[2][2], bv[2][2];
#pragma unroll
        for (int bj = 0; bj < 2; ++bj)
#pragma unroll
            for (int n = 0; n < 2; ++n) { cv[bj][n] = *(const f32x4*)(cs + col0 + bj * HALF + 4 * n); bv[bj][n] = *(const f32x4*)(bw + col0 + bj * HALF + 4 * n); }
#pragma unroll
        for (int ai = 0; ai < 2; ++ai)
#pragma unroll
            for (int m = 0; m < 4; ++m) { const int row = row0 + ai * HALF + m * 16; bf16_t* rowp = O + (size_t)row * ldc + col0;
                const f32x2 st = *(const f32x2*)(ps + (size_t)row * 2); const float rs = st[1], nm = -st[0] * rs;
#pragma unroll
                for (int bj = 0; bj < 2; ++bj) { const f32x4 v0 = acc[ai][bj][m][0] * rs + (cv[bj][0] * nm + bv[bj][0]), v1 = acc[ai][bj][m][1] * rs + (cv[bj][1] * nm + bv[bj][1]);
                    u32x4 w; w.x = cvt_pk_bf16(v0[0], v0[1]); w.y = cvt_pk_bf16(v0[2], v0[3]); w.z = cvt_pk_bf16(v1[0], v1[1]); w.w = cvt_pk_bf16(v1[2], v1[3]);
                    *(u32x4*)(rowp + bj * HALF) = w; } }
    }
};
struct EpiBf16Sel {
    static constexpr bool PERM = true;
    bf16_t *O0, *O1, *O2, *O3;
    __device__ __forceinline__ void operator()(f32x4 (&acc)[2][2][4][2], const Unit& u, int wr, int wc, int fr, int fq) const {
        bf16_t* Ob = u.aux == 0 ? O0 : (u.aux == 1 ? O1 : (u.aux == 2 ? O2 : O3)); const int ld = (u.aux & 1) ? MEMT : DM;
        const int row0 = u.orow + wr * 64 + fr, col0 = u.ocol + wc * 32 + 8 * fq;
#pragma unroll
        for (int ai = 0; ai < 2; ++ai)
#pragma unroll
            for (int m = 0; m < 4; ++m) { bf16_t* rowp = Ob + (size_t)(row0 + ai * HALF + m * 16) * ld + col0;
#pragma unroll
                for (int bj = 0; bj < 2; ++bj) { const f32x4 v0 = acc[ai][bj][m][0], v1 = acc[ai][bj][m][1];
                    u32x4 w; w.x = cvt_pk_bf16(v0[0], v0[1]); w.y = cvt_pk_bf16(v0[2], v0[3]); w.z = cvt_pk_bf16(v1[0], v1[1]); w.w = cvt_pk_bf16(v1[2], v1[3]);
                    *(u32x4*)(rowp + bj * HALF) = w; } }
    }
};
struct EpiExp {
    static constexpr bool PERM = true;
    bf16_t* P; float* rsum; float sc;
    __device__ __forceinline__ void operator()(f32x4 (&acc)[2][2][4][2], const Unit& u, int wr, int wc, int fr, int fq) const {
        const int row0 = u.orow + wr * 64 + fr, col0 = u.ocol + wc * 32 + 8 * fq; const float k2 = sc * 1.4426950408889634f;
#pragma unroll
        for (int ai = 0; ai < 2; ++ai)
#pragma unroll
            for (int m = 0; m < 4; ++m) { const int row = row0 + ai * HALF + m * 16; bf16_t* rowp = P + (size_t)row * 1024 + col0; float s = 0.f;
#pragma unroll
                for (int bj = 0; bj < 2; ++bj) { f32x4 v0 = acc[ai][bj][m][0] * k2, v1 = acc[ai][bj][m][1] * k2;
#pragma unroll
                    for (int e = 0; e < 4; ++e) { v0[e] = __builtin_amdgcn_exp2f(v0[e]); v1[e] = __builtin_amdgcn_exp2f(v1[e]); }
                    s += (v0[0] + v0[1]) + (v0[2] + v0[3]) + (v1[0] + v1[1]) + (v1[2] + v1[3]);
                    u32x4 w; w.x = cvt_pk_bf16(v0[0], v0[1]); w.y = cvt_pk_bf16(v0[2], v0[3]); w.z = cvt_pk_bf16(v1[0], v1[1]); w.w = cvt_pk_bf16(v1[2], v1[3]);
                    *(u32x4*)(rowp + bj * HALF) = w; }
                s += sx(s, 16, fq * 16 + fr); s += sx(s, 32, fq * 16 + fr);
                if (fq == 0) rsum[((size_t)row * 4 + u.aux) * 4 + wc] = s; }
    }
};
struct EpiDivRow {
    static constexpr bool PERM = true;
    bf16_t* O; const float* rsum;
    __device__ __forceinline__ void operator()(f32x4 (&acc)[2][2][4][2], const Unit& u, int wr, int wc, int fr, int fq) const {
        const int row0 = u.orow + wr * 64 + fr, col0 = u.ocol + wc * 32 + 8 * fq;
#pragma unroll
        for (int ai = 0; ai < 2; ++ai)
#pragma unroll
            for (int m = 0; m < 4; ++m) { const int row = row0 + ai * HALF + m * 16; bf16_t* rowp = O + (size_t)row * DM + col0;
                const f32x4 ps = *(const f32x4*)(rsum + ((size_t)row * 4 + u.aux) * 4); const float inv = 1.0f / ((ps[0] + ps[1]) + (ps[2] + ps[3]));
#pragma unroll
                for (int bj = 0; bj < 2; ++bj) { const f32x4 v0 = acc[ai][bj][m][0] * inv, v1 = acc[ai][bj][m][1] * inv;
                    u32x4 w; w.x = cvt_pk_bf16(v0[0], v0[1]); w.y = cvt_pk_bf16(v0[2], v0[3]); w.z = cvt_pk_bf16(v1[0], v1[1]); w.w = cvt_pk_bf16(v1[2], v1[3]);
                    *(u32x4*)(rowp + bj * HALF) = w; } }
    }
};
template <int CTRL> __device__ __forceinline__ float dppf(float old, float src) { return __int_as_float(__builtin_amdgcn_update_dpp(__float_as_int(old), __float_as_int(src), CTRL, 0xf, 0xf, false)); }
struct EpiConvGate {
    static constexpr bool PERM = true;
    bf16_t* act; float* rawH; float* rawT; const float* cw; const float* cb; const float* ps; const float* cs; const float* bw;
    __device__ __forceinline__ void operator()(f32x4 (&acc)[2][2][4][2], const Unit& u, int wr, int wc, int fr, int fq) const {
        const int chb = (u.ocol >> 1) + wc * 32 + 8 * fq;
        {
            const int colq = u.ocol + wc * 32 + 8 * fq;
            float nmv[2][4], rsv[2][4];
#pragma unroll
            for (int ai = 0; ai < 2; ++ai)
#pragma unroll
                for (int m = 0; m < 4; ++m) { const f32x2 st = *(const f32x2*)(ps + (size_t)(u.orow + ai * HALF + wr * 64 + m * 16 + fr) * 2); rsv[ai][m] = st[1]; nmv[ai][m] = -st[0] * st[1]; }
#pragma unroll
            for (int bj = 0; bj < 2; ++bj)
#pragma unroll
                for (int n = 0; n < 2; ++n) { f32x4 cv = *(const f32x4*)(cs + colq + bj * HALF + 4 * n), bv = *(const f32x4*)(bw + colq + bj * HALF + 4 * n);
                    asm volatile("" : "+v"(cv), "+v"(bv));
#pragma unroll
                    for (int ai = 0; ai < 2; ++ai)
#pragma unroll
                        for (int m = 0; m < 4; ++m) acc[ai][bj][m][n] = acc[ai][bj][m][n] * rsv[ai][m] + (cv * nmv[ai][m] + bv); }
        }
#pragma unroll
        for (int ai = 0; ai < 2; ++ai) { const int run = (u.orow + ai * HALF + wr * 64) >> 6;
#pragma unroll
            for (int bj = 0; bj < 2; ++bj)
#pragma unroll
                for (int n = 0; n < 2; ++n) {
                    if (fr < 2) *(f32x4*)(rawH + ((size_t)(run * 2 + fr) * 2 + bj) * DFF + chb + 4 * n) = acc[ai][bj][0][n];
                    if (fr >= 14) *(f32x4*)(rawT + ((size_t)(run * 2 + fr - 14) * 2 + bj) * DFF + chb + 4 * n) = acc[ai][bj][3][n]; } }
        f32x4 w0, w1, w2, bb, nw0, nw1, nw2, nbb;
        { w0 = *(const f32x4*)(cw + chb); w1 = *(const f32x4*)(cw + NUP + chb); w2 = *(const f32x4*)(cw + 2 * NUP + chb); bb = *(const f32x4*)(cb + chb); nw0 = w0; nw1 = w1; nw2 = w2; nbb = bb; }
#pragma unroll
        for (int blk = 0; blk < 8; ++blk) {
            const int ai = blk >> 2, bj = (blk >> 1) & 1, n = blk & 1;
            if (blk < 7) { int chb_ = chb; asm volatile("" : "+v"(chb_));
                const int cidx = (((blk + 1) >> 1) & 1) * DFF + chb_ + 4 * ((blk + 1) & 1);
                nw0 = *(const f32x4*)(cw + cidx); nw1 = *(const f32x4*)(cw + NUP + cidx); nw2 = *(const f32x4*)(cw + 2 * NUP + cidx); nbb = *(const f32x4*)(cb + cidx); }
            asm volatile("" : "+v"(w0), "+v"(w1), "+v"(w2), "+v"(bb));
#pragma unroll
            for (int m = 3; m >= 0; --m) {
                f32x4 v = acc[ai][bj][m][n]; f32x4 pv = (m > 0) ? acc[ai][bj][m > 0 ? m - 1 : 0][n] : (f32x4){0.f, 0.f, 0.f, 0.f};
                asm volatile("" : "+v"(v), "+v"(pv));
                f32x4 r;
#pragma unroll
                for (int e = 0; e < 4; ++e) {
                    const float o1 = dppf<0x121>(0.f, pv[e]), o2 = dppf<0x122>(0.f, pv[e]);
                    const float p1 = dppf<0x111>(o1, v[e]), p2 = dppf<0x112>(o2, v[e]);
                    r[e] = w2[e] * v[e] + w1[e] * p1 + w0[e] * p2 + bb[e];
                }
                asm volatile("" : "+v"(r));
                acc[ai][bj][m][n] = r;
            }
            w0 = nw0; w1 = nw1; w2 = nw2; bb = nbb;
        }
#pragma unroll
        for (int ai = 0; ai < 2; ++ai)
#pragma unroll
            for (int m = 0; m < 4; ++m) { int row = u.orow + ai * HALF + wr * 64 + m * 16 + fr; asm volatile("" : "+v"(row)); f32x4 o[2];
#pragma unroll
                for (int n = 0; n < 2; ++n) { const f32x4 g = acc[ai][0][m][n], up = acc[ai][1][m][n];
#pragma unroll
                    for (int e = 0; e < 4; ++e) o[n][e] = g[e] * __builtin_amdgcn_rcpf(1.0f + __builtin_amdgcn_exp2f(-1.4426950408889634f * g[e])) * up[e]; }
                u32x4 w; w.x = cvt_pk_bf16(o[0][0], o[0][1]); w.y = cvt_pk_bf16(o[0][2], o[0][3]); w.z = cvt_pk_bf16(o[1][0], o[1][1]); w.w = cvt_pk_bf16(o[1][2], o[1][3]);
                *(u32x4*)(act + (size_t)row * DFF + chb) = w; }
    }
};

__device__ __forceinline__ void glds16s(const void* sbase_, unsigned voff, unsigned lds_dst) { unsigned keep;
    const unsigned long long pb_ = (unsigned long long)sbase_;
    const void* sbase = (const void*)(((unsigned long long)(unsigned)__builtin_amdgcn_readfirstlane((int)(pb_ >> 32)) << 32) | (unsigned)__builtin_amdgcn_readfirstlane((int)pb_));
    asm volatile("s_mov_b32 %0, m0\n\ts_mov_b32 m0, %3\n\ts_nop 0\n\tglobal_load_lds_dwordx4 %1, %2\n\ts_mov_b32 m0, %0" : "=&s"(keep) : "v"(voff), "s"(sbase), "s"(lds_dst) : "memory"); }
template <class Epi, class Sched>
__device__ __forceinline__ void gemm_phase(LAS unsigned char* lds, const Gemm g, const Sched& S, const Epi& E, int wave_id) {
    int lane_; asm volatile("v_mbcnt_lo_u32_b32 %0, -1, 0\n\tv_mbcnt_hi_u32_b32 %0, -1, %0" : "=v"(lane_));
    int wid_ = wave_id; asm volatile("" : "+s"(wid_));
    const int wid = wid_, lane = lane_, tid = wid * 64 + lane, wr = wid >> 2, wc = wid & 3, fr = lane & 15, fq = lane >> 4;
    const int nt = g.K / BK;
    unsigned voffA[2], voffB[2];
#pragma unroll
    for (int i = 0; i < 2; ++i) { int R, C; stage_rc(tid * 16 + i * 8192, R, C); const int Rb = Epi::PERM ? ((R & ~31) + perm32(R & 31)) : R;
        voffA[i] = (unsigned)(R * g.lda + C) * 2u; voffB[i] = (unsigned)(Rb * g.ldb + C) * 2u; }
    const size_t kstep = (size_t)(BK * 2);
    const size_t hA = (size_t)HALF * g.lda * 2, hB = (size_t)HALF * g.ldb * 2;
    const unsigned ldsw = (unsigned)wid * 1024u, ldsbase = (unsigned)(unsigned long)lds;
    const int aoff = lds_byte(wr * 64 + fr, fq * 8), boff = lds_byte(wc * 32 + fr, fq * 8);
#define PG8_SA(b, h) (((b) * 2 + (h)) * HTB)
#define PG8_SB(b, h) ((4 + (b) * 2 + (h)) * HTB)
#define PG8_STAGE(bufoff, gbase, voff) do { _Pragma("unroll") for (int _i = 0; _i < 2; ++_i) \
        glds16s((const void*)(gbase), (voff)[_i], (unsigned)__builtin_amdgcn_readfirstlane((int)(ldsbase + (unsigned)(bufoff) + ldsw + _i * 8192u))); } while (0)
#define PG8_LDA(dst, b, h) do { _Pragma("unroll") for (int m = 0; m < 4; ++m) _Pragma("unroll") for (int k = 0; k < 2; ++k) dst[m][k] = *(const LAS bf16x8*)(lds + PG8_SA(b, h) + aoff + m * 2048 + k * 1024); } while (0)
#define PG8_LDB(dst, b, h) do { _Pragma("unroll") for (int n = 0; n < 2; ++n) _Pragma("unroll") for (int k = 0; k < 2; ++k) dst[n][k] = *(const LAS bf16x8*)(lds + PG8_SB(b, h) + boff + n * 2048 + k * 1024); } while (0)
#define PG8_MMA(ai, bj, At, Bt) do { __builtin_amdgcn_s_setprio(1); _Pragma("unroll") for (int m = 0; m < 4; ++m) _Pragma("unroll") for (int n = 0; n < 2; ++n) _Pragma("unroll") for (int k = 0; k < 2; ++k) \
        acc[ai][bj][m][n] = __builtin_amdgcn_mfma_f32_16x16x32_bf16(Bt[n][k], At[m][k], acc[ai][bj][m][n], 0, 0, 0); __builtin_amdgcn_s_setprio(0); } while (0)
#define PG8_WAIT_V(n) asm volatile("s_waitcnt vmcnt(" #n ")" ::: "memory")
#define PG8_WAIT_L(n) asm volatile("s_waitcnt lgkmcnt(" #n ")" ::: "memory")
#define PG8_BAR __builtin_amdgcn_s_barrier()
#define PG8_SCHED __builtin_amdgcn_sched_barrier(0)
    Unit cur, nxt; int ui = 0;
    if (!S.next(0, cur)) return;
    f32x4 acc[2][2][4][2];
#pragma unroll
    for (int a = 0; a < 2; ++a)
#pragma unroll
        for (int b = 0; b < 2; ++b)
#pragma unroll
            for (int m = 0; m < 4; ++m)
#pragma unroll
                for (int n = 0; n < 2; ++n) acc[a][b][m][n] = (f32x4){0.f, 0.f, 0.f, 0.f};
    bf16x8 At[4][2], B0[2][2], B1[2][2];
    const char* cA = (const char*)g.A + cur.a_off; const char* cB = (const char*)g.Bt + cur.b_off;
    PG8_STAGE(PG8_SB(0, 0), cB, voffB); PG8_STAGE(PG8_SB(0, 1), cB + hB, voffB); PG8_STAGE(PG8_SA(0, 0), cA, voffA); PG8_STAGE(PG8_SA(0, 1), cA + hA, voffA);
    if (wr == 1) PG8_BAR;
    PG8_WAIT_V(2); PG8_BAR;
    PG8_STAGE(PG8_SB(1, 0), cB + kstep, voffB); PG8_STAGE(PG8_SA(1, 0), cA + kstep, voffA); PG8_STAGE(PG8_SB(1, 1), cB + hB + kstep, voffB);
    PG8_WAIT_V(6); PG8_BAR;
    for (;;) {
        const bool has_next = S.next(ui + 1, nxt);
        const char* nA = has_next ? (const char*)g.A + nxt.a_off : cA; const char* nB = has_next ? (const char*)g.Bt + nxt.b_off : cB;
        for (int t = 0; t < nt; t += 2) {
            const bool last = (t == nt - 2);
            const char* a1 = cA + (size_t)(t + 1) * kstep;
            const char* a2 = last ? nA : cA + (size_t)(t + 2) * kstep; const char* b2 = last ? nB : cB + (size_t)(t + 2) * kstep;
            const char* a3 = a2 + kstep; const char* b3 = b2 + kstep;
            PG8_LDB(B0, 0, 0); PG8_LDB(B1, 0, 1); PG8_SCHED; PG8_LDA(At, 0, 0); PG8_STAGE(PG8_SA(1, 1), a1 + hA, voffA);
            PG8_WAIT_V(8); PG8_WAIT_L(0); PG8_BAR; PG8_MMA(0, 0, At, B0); PG8_MMA(0, 1, At, B1); PG8_BAR; PG8_SCHED;
            PG8_LDA(At, 0, 1); PG8_STAGE(PG8_SB(0, 0), b2, voffB); PG8_STAGE(PG8_SB(0, 1), b2 + hB, voffB); PG8_STAGE(PG8_SA(0, 0), a2, voffA);
            PG8_WAIT_V(8); PG8_WAIT_L(0); PG8_BAR; PG8_MMA(1, 0, At, B0); PG8_MMA(1, 1, At, B1); PG8_BAR; PG8_SCHED;
            PG8_LDB(B0, 1, 0); PG8_LDB(B1, 1, 1); PG8_SCHED; PG8_LDA(At, 1, 0); PG8_STAGE(PG8_SA(0, 1), a2 + hA, voffA);
            PG8_WAIT_V(8); PG8_WAIT_L(0); PG8_BAR; PG8_MMA(0, 0, At, B0); PG8_MMA(0, 1, At, B1); PG8_BAR; PG8_SCHED;
            PG8_LDA(At, 1, 1); PG8_STAGE(PG8_SB(1, 0), b3, voffB); PG8_STAGE(PG8_SB(1, 1), b3 + hB, voffB); PG8_STAGE(PG8_SA(1, 0), a3, voffA);
            PG8_WAIT_V(8); PG8_WAIT_L(0); PG8_BAR; PG8_MMA(1, 0, At, B0); PG8_MMA(1, 1, At, B1); PG8_BAR; PG8_SCHED;
        }
        if (wr == 0) PG8_BAR;
        E(acc, cur, wr, wc, fr, fq);
        if (!has_next) break;
#pragma unroll
        for (int a = 0; a < 2; ++a)
#pragma unroll
            for (int b = 0; b < 2; ++b)
#pragma unroll
                for (int m = 0; m < 4; ++m)
#pragma unroll
                    for (int n = 0; n < 2; ++n) acc[a][b][m][n] = (f32x4){0.f, 0.f, 0.f, 0.f};
        cur = nxt; cA = nA; cB = nB; ++ui;
        if (wr == 1) PG8_BAR;
    }
    PG8_WAIT_V(0);
    PG8_BAR;
#undef PG8_SA
#undef PG8_SB
#undef PG8_STAGE
#undef PG8_LDA
#undef PG8_LDB
#undef PG8_MMA
#undef PG8_WAIT_V
#undef PG8_WAIT_L
#undef PG8_BAR
#undef PG8_SCHED
}
}

__device__ __forceinline__ unsigned f2bf(float f) { unsigned u = __builtin_bit_cast(unsigned, f); return (u + 0x7fffu + ((u >> 16) & 1u)) >> 16; }
__device__ __forceinline__ unsigned pk2(float lo, float hi) { return f2bf(lo) | (f2bf(hi) << 16); }
__device__ __forceinline__ float wave_sum(float v, int lane) {
#pragma unroll
    for (int o = 1; o < 64; o <<= 1) v += sx(v, o, lane);
    return v;
}
#define LDS_WAIT() asm volatile("s_waitcnt lgkmcnt(0)" ::: "memory")

struct Params {
    const float* in[23]; float* out; unsigned char* ws;
};

__device__ __forceinline__ void transpose_item(const float* W, int K, int N, bf16_t* WT, int mode, LAS float* scr, int item, int lane, const float* gvec, const float* bvec, float* csp, int nblk, int nmagic) {
    const int kb = (item * nmagic) >> 20, nb = item - kb * nblk, k0 = 64 * kb, n0 = 64 * nb;
    int r0 = n0;
    if (mode == 1) { const int bj = n0 / DFF, rem = n0 % DFF; r0 = 256 * (rem / 128) + 128 * bj + (rem % 128); }
    const int rr = lane >> 4, q = lane & 15;
    f32x4 t[16];
#pragma unroll
    for (int i = 0; i < 16; ++i) t[i] = *(const f32x4*)(W + (size_t)(k0 + 4 * i + rr) * N + n0 + 4 * q);
#pragma unroll
    for (int i = 0; i < 16; ++i) { LAS float* d = scr + (4 * i + rr) * 65 + 4 * q; d[0] = t[i][0]; d[1] = t[i][1]; d[2] = t[i][2]; d[3] = t[i][3]; }
    LDS_WAIT(); asm volatile("" ::: "memory");
    const int c = lane & 7;
    if (csp) {
        f32x4 g0 = (f32x4){1.f, 1.f, 1.f, 1.f}, g1 = g0, b0 = (f32x4){0.f, 0.f, 0.f, 0.f}, b1 = b0;
        if (gvec) { g0 = *(const f32x4*)(gvec + k0 + 8 * c); g1 = *(const f32x4*)(gvec + k0 + 8 * c + 4); b0 = *(const f32x4*)(bvec + k0 + 8 * c); b1 = *(const f32x4*)(bvec + k0 + 8 * c + 4); }
#pragma unroll
        for (int j = 0; j < 8; ++j) { const int n = (lane >> 3) + 8 * j; const LAS float* sp = scr + (8 * c) * 65 + n;
            const float w0 = sp[0 * 65], w1 = sp[1 * 65], w2 = sp[2 * 65], w3 = sp[3 * 65], w4 = sp[4 * 65], w5 = sp[5 * 65], w6 = sp[6 * 65], w7 = sp[7 * 65];
            u32x4 o; o.x = pk2(w0 * g0[0], w1 * g0[1]); o.y = pk2(w2 * g0[2], w3 * g0[3]); o.z = pk2(w4 * g1[0], w5 * g1[1]); o.w = pk2(w6 * g1[2], w7 * g1[3]);
            *(u32x4*)(WT + (size_t)(r0 + n) * K + k0 + 8 * c) = o;
            float cs = ((bflo(o.x) + bfhi(o.x)) + (bflo(o.y) + bfhi(o.y))) + ((bflo(o.z) + bfhi(o.z)) + (bflo(o.w) + bfhi(o.w)));
            float bs = ((w0 * b0[0] + w1 * b0[1]) + (w2 * b0[2] + w3 * b0[3])) + ((w4 * b1[0] + w5 * b1[1]) + (w6 * b1[2] + w7 * b1[3]));
            cs += sx(cs, 1, lane); bs += sx(bs, 1, lane); cs += sx(cs, 2, lane); bs += sx(bs, 2, lane); cs += sx(cs, 4, lane); bs += sx(bs, 4, lane);
            if (c == 0) { f32x2 o2; o2[0] = cs; o2[1] = bs; *(f32x2*)(csp + ((size_t)kb * NCOLS + r0 + n) * 2) = o2; } }
    } else {
#pragma unroll
        for (int j = 0; j < 8; ++j) { const int n = (lane >> 3) + 8 * j; const LAS float* sp = scr + (8 * c) * 65 + n;
            u32x4 o; o.x = pk2(sp[0 * 65], sp[1 * 65]); o.y = pk2(sp[2 * 65], sp[3 * 65]); o.z = pk2(sp[4 * 65], sp[5 * 65]); o.w = pk2(sp[6 * 65], sp[7 * 65]);
            *(u32x4*)(WT + (size_t)(r0 + n) * K + k0 + 8 * c) = o; }
    }
    LDS_WAIT(); asm volatile("" ::: "memory");
}

__device__ __forceinline__ void ln_row_bf(const float* xin, bf16_t* ybf, float* stat, const float* g, const float* b, int lane) {
    const f32x4* xr = (const f32x4*)xin + lane;
    f32x4 v[8]; float s = 0.f;
#pragma unroll
    for (int j = 0; j < 8; ++j) { v[j] = xr[64 * j]; s += (v[j][0] + v[j][1]) + (v[j][2] + v[j][3]); }
    const float mean = wave_sum(s, lane) * (1.f / DM); float s2 = 0.f;
#pragma unroll
    for (int j = 0; j < 8; ++j) { v[j] = v[j] - mean; s2 += (v[j][0] * v[j][0] + v[j][1] * v[j][1]) + (v[j][2] * v[j][2] + v[j][3] * v[j][3]); }
    const float rstd = 1.f / sqrtf(wave_sum(s2, lane) * (1.f / DM) + LN_EPS);
    if (lane == 0) { stat[0] = mean; stat[1] = rstd; }
    u32x2* o8 = (u32x2*)ybf + lane;
#pragma unroll
    for (int j = 0; j < 8; ++j) { const f32x4 gg = ((const f32x4*)g)[lane + 64 * j], bb = ((const f32x4*)b)[lane + 64 * j];
        const f32x4 y = v[j] * rstd * gg + bb; u32x2 w; w.x = pk2(y[0], y[1]); w.y = pk2(y[2], y[3]); o8[64 * j] = w; }
}
__device__ __forceinline__ void ln_row(const float* xin, float* yout, bf16_t* ybf, const float* g, const float* b, int lane) {
    const f32x4* xr = (const f32x4*)xin + lane;
    f32x4 v[8]; float s = 0.f;
#pragma unroll
    for (int j = 0; j < 8; ++j) { v[j] = xr[64 * j]; s += (v[j][0] + v[j][1]) + (v[j][2] + v[j][3]); }
    const float mean = wave_sum(s, lane) * (1.f / DM); float s2 = 0.f;
#pragma unroll
    for (int j = 0; j < 8; ++j) { v[j] = v[j] - mean; s2 += (v[j][0] * v[j][0] + v[j][1] * v[j][1]) + (v[j][2] * v[j][2] + v[j][3] * v[j][3]); }
    const float rstd = 1.f / sqrtf(wave_sum(s2, lane) * (1.f / DM) + LN_EPS);
    f32x4* yo = (f32x4*)yout + lane; u32x2* o8 = (u32x2*)ybf + lane;
#pragma unroll
    for (int j = 0; j < 8; ++j) { const f32x4 gg = ((const f32x4*)g)[lane + 64 * j], bb = ((const f32x4*)b)[lane + 64 * j];
        const f32x4 y = v[j] * rstd * gg + bb; yo[64 * j] = y; if (ybf) { u32x2 w; w.x = pk2(y[0], y[1]); w.y = pk2(y[2], y[3]); o8[64 * j] = w; } }
}

template <bool DO_DIFF, bool DO_DIL>
__device__ __forceinline__ void simple_attn_task(const bf16_t* proj, bf16_t* xo, int b, int h, int qb16, float lam, float lam_init, const float* g_diff, const float* g_dil, int lane, LAS float* resl) {
    const int ql = lane & 15, dvq = lane >> 4;
    const int t = qb16 * 16 + ql;
    const size_t rowb = (size_t)b * SEQ;
    const bf16_t* qrow = proj + (rowb + t) * NIN;
    if constexpr (DO_DIFF) {
        const float slope = exp2f(-(float)(2 * h + 1) * 0.5f);
#pragma unroll 1
        for (int c = 0; c < 2; ++c) {
            asm volatile("" ::: "memory");
            unsigned q[32];
            { const u32x4* qp = (const u32x4*)(qrow + h * 128 + c * 64);
#pragma unroll
              for (int i = 0; i < 8; ++i) { const u32x4 w = qp[i]; q[4 * i] = w[0]; q[4 * i + 1] = w[1]; q[4 * i + 2] = w[2]; q[4 * i + 3] = w[3]; } }
            float o[32];
#pragma unroll
            for (int d = 0; d < 32; ++d) o[d] = 0.f;
            float m = -1e30f, l = 0.f;
            const int kend = qb16 * 16 + 16;
#pragma unroll 1
            for (int k = 0; k < kend; ++k) {
                const bf16_t* krow = proj + (rowb + k) * NIN;
                const u32x4* kp = (const u32x4*)(krow + 1024 + h * 128 + c * 64);
                float s = 0.f;
#pragma unroll
                for (int i = 0; i < 8; ++i) { const u32x4 w = kp[i];
#pragma unroll
                    for (int e = 0; e < 4; ++e) { s += bflo(q[4 * i + e]) * bflo(w[e]); s += bfhi(q[4 * i + e]) * bfhi(w[e]); } }
                s = s * 0.125f - slope * (float)(t - k);
                asm volatile("" : "+v"(s) :: "memory");
                if (k <= t) {
                    if (s > m) { const float a = __expf(m - s); l *= a;
#pragma unroll
                        for (int d = 0; d < 32; ++d) o[d] *= a;
                        m = s; }
                    const float pr = __expf(s - m); l += pr;
                    const u32x4* vp = (const u32x4*)(krow + 2048 + h * 128 + dvq * 32);
#pragma unroll
                    for (int i = 0; i < 4; ++i) { const u32x4 w = vp[i];
#pragma unroll
                        for (int e = 0; e < 4; ++e) { o[8 * i + 2 * e] += pr * bflo(w[e]); o[8 * i + 2 * e + 1] += pr * bfhi(w[e]); } }
                }
            }
            const float inv = 1.f / l;
            if (c == 0) {
#pragma unroll
                for (int d = 0; d < 32; ++d) resl[d * 512] = o[d] * inv;
            } else {
                float ss = 0.f;
#pragma unroll
                for (int d = 0; d < 32; ++d) { if ((d & 7) == 0) asm volatile("" ::: "memory"); o[d] = resl[d * 512] - lam * o[d] * inv; ss += o[d] * o[d]; }
                ss += sx(ss, 16, lane); ss += sx(ss, 32, lane);
                const float r = (1.f / sqrtf(ss * (1.f / 128.f) + RMS_EPS)) * (1.f - lam_init);
                unsigned* op = (unsigned*)(xo + (rowb + t) * DM + h * 128 + dvq * 32);
#pragma unroll
                for (int d = 0; d < 32; d += 2) { if ((d & 7) == 0) asm volatile("" ::: "memory"); op[d >> 1] = pk2(o[d] * r * g_diff[dvq * 32 + d], o[d + 1] * r * g_diff[dvq * 32 + d + 1]); }
            }
        }
    }
    if constexpr (DO_DIL) {
        asm volatile("" ::: "memory");
        const float slope = exp2f(-(float)(h + 1));
        const float scale = 0.08838834764831845f;
        unsigned qpk[64];
        { const u32x4* qp = (const u32x4*)(qrow + 3072 + h * 128);
#pragma unroll
          for (int i = 0; i < 16; ++i) { const u32x4 w = qp[i]; qpk[4 * i] = w[0]; qpk[4 * i + 1] = w[1]; qpk[4 * i + 2] = w[2]; qpk[4 * i + 3] = w[3]; } }
        float o[32];
#pragma unroll
        for (int d = 0; d < 32; ++d) o[d] = 0.f;
        float m = -1e30f, l = 0.f;
#pragma unroll 1
        for (int br = 0; br < 3; ++br) {
            const int dil = br == 0 ? 1 : (br == 1 ? 4 : 16);
            const int p = t / dil;
#pragma unroll 1
            for (int j = 0; j <= 128; ++j) {
                if (j <= p) {
                    const int k = t - j * dil;
                    const bf16_t* krow = proj + (rowb + k) * NIN;
                    const u32x4* kp = (const u32x4*)(krow + 4096 + h * 128);
                    float s = 0.f;
#pragma unroll
                    for (int i = 0; i < 16; ++i) { const u32x4 w = kp[i];
#pragma unroll
                        for (int e = 0; e < 4; ++e) { s += bflo(qpk[4 * i + e]) * bflo(w[e]); s += bfhi(qpk[4 * i + e]) * bfhi(w[e]); } }
                    s = s * scale - slope * (float)(j * dil);
                    asm volatile("" : "+v"(s) :: "memory");
                    if (s > m) { const float a = __expf(m - s); l *= a;
#pragma unroll
                        for (int d = 0; d < 32; ++d) o[d] *= a;
                        m = s; }
                    const float pr = __expf(s - m); l += pr;
                    const u32x4* vp = (const u32x4*)(krow + 5120 + h * 128 + dvq * 32);
#pragma unroll
                    for (int i = 0; i < 4; ++i) { const u32x4 w = vp[i];
#pragma unroll
                        for (int e = 0; e < 4; ++e) { o[8 * i + 2 * e] += pr * bflo(w[e]); o[8 * i + 2 * e + 1] += pr * bfhi(w[e]); } }
                }
            }
        }
        const float inv = 1.f / l; float ss = 0.f;
#pragma unroll
        for (int d = 0; d < 32; ++d) { o[d] *= inv; ss += o[d] * o[d]; }
        ss += sx(ss, 16, lane); ss += sx(ss, 32, lane);
        const float r = 1.f / sqrtf(ss * (1.f / 128.f) + RMS_EPS);
        unsigned* op = (unsigned*)(xo + (rowb + t) * DM + 1024 + h * 128 + dvq * 32);
#pragma unroll
        for (int d = 0; d < 32; d += 2) { if ((d & 7) == 0) asm volatile("" ::: "memory"); op[d >> 1] = pk2(o[d] * r * g_dil[dvq * 32 + d], o[d + 1] * r * g_dil[dvq * 32 + d + 1]); }
    }
}


typedef float f32x16 __attribute__((ext_vector_type(16)));
typedef short s16x4 __attribute__((ext_vector_type(4)));
#define MFMA32(a, b, c) __builtin_amdgcn_mfma_f32_32x32x16_bf16((a), (b), (c), 0, 0, 0)
constexpr int VROWB = 320;
constexpr float LOG2E = 1.4426950408889634f, NEGBIG = -1e30f;
__device__ __forceinline__ s16x4 vtr(const LAS unsigned char* p) { return __builtin_bit_cast(s16x4, __builtin_amdgcn_ds_read_tr16_b64_v4i16((LAS s16x4*)p)); }
__device__ __forceinline__ int crow(int r, int hi) { return (r & 3) + 8 * (r >> 2) + 4 * hi; }
__device__ __forceinline__ void load_v(u32x4 (&t)[8], const bf16_t* vbase  , int rstride, unsigned voff  ) {
#pragma unroll
    for (int i = 0; i < 8; ++i) t[i] = *(const u32x4*)((const char*)(vbase + (size_t)(4 * i * rstride) * NIN) + voff);
}
__device__ __forceinline__ void store_v(LAS unsigned char* vl, const u32x4 (&t)[8], int lane) {
    const int rr = lane >> 4, ch = lane & 15;
#pragma unroll
    for (int i = 0; i < 8; ++i) *(LAS u32x4*)(vl + (4 * i + rr) * VROWB + ch * 16) = t[i];
}
constexpr int KROWB = 272;
constexpr int WAVE_LDS = 32 * VROWB + 32 * KROWB;
__device__ __forceinline__ void store_k(LAS unsigned char* kl, const u32x4 (&t)[8], int lane) {
    const int rr = lane >> 4, ch = lane & 15;
#pragma unroll
    for (int i = 0; i < 8; ++i) *(LAS u32x4*)(kl + (4 * i + rr) * KROWB + ch * 16) = t[i];
}
__device__ __forceinline__ void read_kf(bf16x8 (&kf)[8], const LAS unsigned char* klane  ) {
#pragma unroll
    for (int d0 = 0; d0 < 8; ++d0) kf[d0] = *(const LAS bf16x8*)(klane + 32 * d0);
}
__device__ __forceinline__ void pv_chunk(f32x16 (&ot)[4], const LAS unsigned char* vtb, bf16x8 pf0, bf16x8 pf1) {
#pragma unroll
    for (int db = 0; db < 4; ++db)
#pragma unroll
        for (int s = 0; s < 2; ++s) {
            const s16x4 a = vtr(vtb + (16 * s) * VROWB + 64 * db), b2 = vtr(vtb + (16 * s + 8) * VROWB + 64 * db);
            const bf16x8 vf = (bf16x8){a[0], a[1], a[2], a[3], b2[0], b2[1], b2[2], b2[3]};
            __builtin_amdgcn_s_setprio(1); ot[db] = MFMA32(vf, s ? pf1 : pf0, ot[db]); __builtin_amdgcn_s_setprio(0);
        }
}
__device__ __forceinline__ bf16x8 pack8(const float* p) {
    u32x4 w; w.x = pg8::cvt_pk_bf16(p[0], p[1]); w.y = pg8::cvt_pk_bf16(p[2], p[3]); w.z = pg8::cvt_pk_bf16(p[4], p[5]); w.w = pg8::cvt_pk_bf16(p[6], p[7]);
    return __builtin_bit_cast(bf16x8, w);
}
__device__ __forceinline__ void store_rows_wide(bf16_t* op  , u32x2 (&o2)[16], int hi) {
#pragma unroll
    for (int k = 0; k < 16; k += 2) { u32x2 a = o2[k], b = o2[k + 1];
        { auto r = __builtin_amdgcn_permlane32_swap(a.x, b.x, false, false); a.x = r[0]; b.x = r[1]; }
        { auto r = __builtin_amdgcn_permlane32_swap(a.y, b.y, false, false); a.y = r[0]; b.y = r[1]; }
        u32x4 w; w.x = a.x; w.y = a.y; w.z = b.x; w.w = b.y;
        *(u32x4*)(op + 8 * k + 8 * hi) = w; }
}
__device__ __forceinline__ void diff_task(const bf16_t* proj, bf16_t* xo, int b, int h, int qb, float lam, float post, const float* g_diff, int  , LAS unsigned char* vl) {
    int lane; asm volatile("v_mbcnt_lo_u32_b32 %0, -1, 0\n\tv_mbcnt_hi_u32_b32 %0, -1, %0" : "=v"(lane));
    const int r32 = lane & 31, hi = lane >> 5;
    const size_t rowb = (size_t)b * SEQ;
    const int qpos = qb * 32 + r32;
    const float slope = exp2f(-(float)(2 * h + 1) * 0.5f);
    const float c1 = 0.125f * LOG2E, c2 = slope * LOG2E, c2s = c2 * 32.f;
    bf16x8 qf[8];
    { const bf16_t* qp = proj + (rowb + qpos) * NIN + h * 128 + 8 * hi;
#pragma unroll
      for (int d0 = 0; d0 < 8; ++d0) qf[d0] = *(const bf16x8*)(qp + 16 * d0); }
    const bf16_t* kcol = proj + 1024 + h * 128 + rowb * NIN;
    const bf16_t* vcol = proj + 2048 + h * 128 + rowb * NIN;
    const unsigned voff = (unsigned)((lane >> 4) * NIN + (lane & 15) * 8) * 2u;
    LAS unsigned char* kl = vl + 32 * VROWB;
    const LAS unsigned char* klane = kl + r32 * KROWB + 16 * hi;
    const float bb = -c2 * (float)(qpos - 4 * hi);
#define B0(r) (bb + c2 * (float)(((r) & 3) + 8 * ((r) >> 2)))
    float m0 = NEGBIG, l0 = 0.f, m1 = NEGBIG, l1 = 0.f;
    bf16x8 kf[8]; u32x4 kr[8];
    float sh = 0.f;
    {
        u32x4 krb[8];
        const LAS unsigned char* klaneB = vl + r32 * VROWB + 16 * hi;
        load_v(kr, kcol, 1, voff);
        load_v(krb, kcol + (size_t)((qb >= 1 ? 1 : 0) * 32) * NIN, 1, voff);
        store_k(kl, kr, lane); store_v(vl, krb, lane);
#define DIFF_STATS(S0, S1, KC) do { \
            _Pragma("unroll") for (int r = 0; r < 16; ++r) { const float bq = B0(r); S0[r] = S0[r] * c1 + bq; S1[r] = S1[r] * c1 + bq; } \
            if ((KC) == qb) { _Pragma("unroll") for (int r = 0; r < 16; ++r) if (crow(r, hi) > r32) { S0[r] = NEGBIG; S1[r] = NEGBIG; } } \
            float cm0 = S0[0], cm1 = S1[0]; \
            _Pragma("unroll") for (int r = 1; r < 16; ++r) { cm0 = fmaxf(cm0, S0[r]); cm1 = fmaxf(cm1, S1[r]); } \
            const float shk = c2s * (float)(KC); \
            const float n0 = fmaxf(m0, cm0 + shk), n1 = fmaxf(m1, cm1 + shk), e0 = n0 - shk, e1 = n1 - shk; \
            float a0 = 0.f, a1 = 0.f; \
            _Pragma("unroll") for (int r = 0; r < 16; ++r) { a0 += __builtin_amdgcn_exp2f(S0[r] - e0); a1 += __builtin_amdgcn_exp2f(S1[r] - e1); } \
            l0 = l0 * __builtin_amdgcn_exp2f(m0 - n0) + a0; l1 = l1 * __builtin_amdgcn_exp2f(m1 - n1) + a1; m0 = n0; m1 = n1; } while (0)
#pragma unroll 1
        for (int kc = 0; kc <= qb; kc += 2) {
            f32x16 sa0 = {}, sa1 = {}, sb0 = {}, sb1 = {};
            read_kf(kf, klane);
#pragma unroll
            for (int d0 = 0; d0 < 4; ++d0) { sa0 = MFMA32(kf[d0], qf[d0], sa0); sa1 = MFMA32(kf[4 + d0], qf[4 + d0], sa1); }
            read_kf(kf, klaneB);
#pragma unroll
            for (int d0 = 0; d0 < 4; ++d0) { sb0 = MFMA32(kf[d0], qf[d0], sb0); sb1 = MFMA32(kf[4 + d0], qf[4 + d0], sb1); }
            const int ka = kc + 2 <= qb ? kc + 2 : qb, kb2 = kc + 3 <= qb ? kc + 3 : qb;
            load_v(kr, kcol + (size_t)(ka * 32) * NIN, 1, voff);
            DIFF_STATS(sa0, sa1, kc);
            asm volatile("" : "+v"(m0), "+v"(l0), "+v"(m1), "+v"(l1));
            load_v(krb, kcol + (size_t)(kb2 * 32) * NIN, 1, voff);
            if (kc + 1 <= qb) DIFF_STATS(sb0, sb1, kc + 1);
            store_k(kl, kr, lane); store_v(vl, krb, lane);
        }
#undef DIFF_STATS
    }
    { const float mo0 = sx(m0, 32, lane), lo0 = sx(l0, 32, lane), mo1 = sx(m1, 32, lane), lo1 = sx(l1, 32, lane);
      const float M0 = fmaxf(m0, mo0), M1 = fmaxf(m1, mo1);
      l0 = l0 * __builtin_amdgcn_exp2f(m0 - M0) + lo0 * __builtin_amdgcn_exp2f(mo0 - M0); l1 = l1 * __builtin_amdgcn_exp2f(m1 - M1) + lo1 * __builtin_amdgcn_exp2f(mo1 - M1); m0 = M0; m1 = M1; }
    const float i0 = 1.0f / l0, i1 = lam / l1;
    f32x16 ot[4];
#pragma unroll
    for (int db = 0; db < 4; ++db) ot[db] = (f32x16){};
    const int g = lane >> 4, ii = lane & 15;
    const LAS unsigned char* vtb = vl + (4 * (g >> 1) + (ii >> 2)) * VROWB + (16 * (g & 1) + 4 * (ii & 3)) * 2;
    u32x4 vr[8];
    load_v(vr, vcol, 1, voff);
    load_v(kr, kcol, 1, voff);
    store_v(vl, vr, lane);
    store_k(kl, kr, lane);
    sh = 0.f;
#pragma unroll 1
    for (int kc = 0; kc <= qb; ++kc) {
        read_kf(kf, klane);
        f32x16 s0 = {}, s1 = {};
#pragma unroll
        for (int d0 = 0; d0 < 4; ++d0) { s0 = MFMA32(kf[d0], qf[d0], s0); s1 = MFMA32(kf[4 + d0], qf[4 + d0], s1); }
        const int kn = kc < qb ? kc + 1 : kc;
        load_v(kr, kcol + (size_t)(kn * 32) * NIN, 1, voff);
        if (kc == qb) {
#pragma unroll
            for (int r = 0; r < 16; ++r) if (crow(r, hi) > r32) { s0[r] = NEGBIG; s1[r] = NEGBIG; }
        }
        const float e0 = m0 - sh, e1 = m1 - sh;
        float p[16];
#pragma unroll
        for (int r = 0; r < 16; ++r) { const float bq0 = B0(r) - e0, bq1 = B0(r) - e1; p[r] = __builtin_amdgcn_exp2f(s0[r] * c1 + bq0) * i0 - __builtin_amdgcn_exp2f(s1[r] * c1 + bq1) * i1; }
        bf16x8 pf0 = pack8(p), pf1 = pack8(p + 8);
        asm volatile("" : "+v"(pf0), "+v"(pf1));
        load_v(vr, vcol + (size_t)(kn * 32) * NIN, 1, voff);
        pv_chunk(ot, vtb, pf0, pf1);
        store_k(kl, kr, lane);
        store_v(vl, vr, lane);
        sh += c2s;
    }
    float ss = 0.f;
#pragma unroll
    for (int db = 0; db < 4; ++db)
#pragma unroll
        for (int r = 0; r < 16; ++r) ss += ot[db][r] * ot[db][r];
    ss += sx(ss, 32, lane);
    const float rn = (1.0f / sqrtf(ss * (1.f / 128.f) + RMS_EPS)) * post;
    bf16_t* op = xo + (rowb + qpos) * DM + h * 128;
    u32x2 o2[16];
#pragma unroll
    for (int db = 0; db < 4; ++db)
#pragma unroll
        for (int rg = 0; rg < 4; ++rg) { const int d = 32 * db + 8 * rg + 4 * hi; const f32x4 gg = *(const f32x4*)(g_diff + d);
            u32x2 w; w.x = pg8::cvt_pk_bf16(ot[db][4 * rg] * rn * gg[0], ot[db][4 * rg + 1] * rn * gg[1]); w.y = pg8::cvt_pk_bf16(ot[db][4 * rg + 2] * rn * gg[2], ot[db][4 * rg + 3] * rn * gg[3]);
            o2[4 * db + rg] = w; }
    store_rows_wide(op, o2, hi);
}
__device__ __forceinline__ void dil_task(const bf16_t* proj, bf16_t* po, int ldo, float* lse, int b, int h, int dil, int c, int pb, int  , LAS unsigned char* vl) {
    int lane; asm volatile("v_mbcnt_lo_u32_b32 %0, -1, 0\n\tv_mbcnt_hi_u32_b32 %0, -1, %0" : "=v"(lane));
    const int r32 = lane & 31, hi = lane >> 5;
    const size_t row0 = (size_t)b * SEQ + c;
    const size_t qrow = row0 + (size_t)(pb * 32 + r32) * dil;
    const float slope = exp2f(-(float)(h + 1));
    const float c1 = 0.08838834764831845f * LOG2E, c2 = slope * LOG2E * (float)dil, c2s = c2 * 32.f;
    bf16x8 qf[8];
    { const bf16_t* qp = proj + qrow * NIN + 3072 + h * 128 + 8 * hi;
#pragma unroll
      for (int d0 = 0; d0 < 8; ++d0) qf[d0] = *(const bf16x8*)(qp + 16 * d0); }
    const bf16_t* kcol = proj + 4096 + h * 128 + row0 * NIN;
    const bf16_t* vcol = proj + 5120 + h * 128 + row0 * NIN;
    const unsigned voff = (unsigned)((lane >> 4) * dil * NIN + (lane & 15) * 8) * 2u;
    const size_t cstep = (size_t)32 * dil;
    const int g = lane >> 4, ii = lane & 15;
    const LAS unsigned char* vtb = vl + (4 * (g >> 1) + (ii >> 2)) * VROWB + (16 * (g & 1) + 4 * (ii & 3)) * 2;
    LAS unsigned char* kl = vl + 32 * VROWB;
    const LAS unsigned char* klane = kl + r32 * KROWB + 16 * hi;
    const float bb = -c2 * (float)(r32 - 4 * hi);
    f32x16 ot[4];
#pragma unroll
    for (int db = 0; db < 4; ++db) ot[db] = (f32x16){};
    float m = NEGBIG, l = 0.f;
    const int kc0 = pb >= 4 ? pb - 4 : 0;
    bf16x8 kf[8]; u32x4 vr[8], kr[8];
    load_v(vr, vcol + kc0 * cstep * NIN, dil, voff);
    load_v(kr, kcol + kc0 * cstep * NIN, dil, voff);
    store_v(vl, vr, lane);
    store_k(kl, kr, lane);
    float sh = -c2s * (float)(pb - kc0);
#pragma unroll 1
    for (int kc = kc0; kc <= pb; ++kc) {
        read_kf(kf, klane);
        f32x16 st = {};
#pragma unroll
        for (int d0 = 0; d0 < 8; ++d0) st = MFMA32(kf[d0], qf[d0], st);
        const int kn = kc < pb ? kc + 1 : kc;
        load_v(kr, kcol + kn * cstep * NIN, dil, voff);
#pragma unroll
        for (int r = 0; r < 16; ++r) st[r] = st[r] * c1 + B0(r);
        if (kc == pb) {
#pragma unroll
            for (int r = 0; r < 16; ++r) if (crow(r, hi) > r32) st[r] = NEGBIG;
        }
        if (kc + 4 == pb) {
#pragma unroll
            for (int r = 0; r < 16; ++r) if (crow(r, hi) < r32) st[r] = NEGBIG;
        }
        float cm = st[0];
#pragma unroll
        for (int r = 1; r < 16; ++r) cm = fmaxf(cm, st[r]);
        cm = fmaxf(cm, sx(cm, 32, lane)) + sh;
        if (__builtin_amdgcn_ballot_w64(cm > m + 8.0f) != 0ull) {
            const float mn = fmaxf(m, cm), al = __builtin_amdgcn_exp2f(m - mn);
            m = mn; l *= al;
#pragma unroll
            for (int db = 0; db < 4; ++db) ot[db] = ot[db] * al;
        }
        const float e = m - sh;
        float p[16]; float a = 0.f;
#pragma unroll
        for (int r = 0; r < 16; ++r) { p[r] = __builtin_amdgcn_exp2f(st[r] - e); a += p[r]; }
        l += a;
        bf16x8 pf0 = pack8(p), pf1 = pack8(p + 8);
        asm volatile("" : "+v"(pf0), "+v"(pf1));
        load_v(vr, vcol + kn * cstep * NIN, dil, voff);
        pv_chunk(ot, vtb, pf0, pf1);
        store_k(kl, kr, lane);
        store_v(vl, vr, lane);
        sh += c2s;
    }
    l += sx(l, 32, lane);
    const float inv = 1.0f / l;
    bf16_t* op = po + qrow * ldo + h * 128;
    { u32x2 o2[16];
#pragma unroll
      for (int db = 0; db < 4; ++db)
#pragma unroll
          for (int rg = 0; rg < 4; ++rg) { u32x2 w; w.x = pg8::cvt_pk_bf16(ot[db][4 * rg] * inv, ot[db][4 * rg + 1] * inv); w.y = pg8::cvt_pk_bf16(ot[db][4 * rg + 2] * inv, ot[db][4 * rg + 3] * inv); o2[4 * db + rg] = w; }
      store_rows_wide(op, o2, hi); }
    if (hi == 0) lse[qrow * 8 + h] = m + __builtin_amdgcn_logf(l);
}
__device__ __forceinline__ void dil_combine_load(float (&o)[16], float& rn, const bf16_t* p0, const bf16_t* p1, const bf16_t* xo, const float* lse0, const float* lse1, const float* lse2, int lane) {
    const int h = lane >> 3, seg = lane & 7;
    const float e0 = lse0[h], e1 = lse1[h], e2 = lse2[h], em = fmaxf(e0, fmaxf(e1, e2));
    float w0 = __builtin_amdgcn_exp2f(e0 - em), w1 = __builtin_amdgcn_exp2f(e1 - em), w2 = __builtin_amdgcn_exp2f(e2 - em); const float wi = 1.0f / (w0 + w1 + w2); w0 *= wi; w1 *= wi; w2 *= wi;
    const int off = h * 128 + seg * 16;
    float ss = 0.f;
#pragma unroll
    for (int j = 0; j < 2; ++j) { const u32x4 a = *(const u32x4*)(p0 + off + 8 * j), bq = *(const u32x4*)(p1 + off + 8 * j), cq = *(const u32x4*)(xo + off + 8 * j);
#pragma unroll
        for (int e = 0; e < 4; ++e) { o[8 * j + 2 * e] = w0 * bflo(a[e]) + w1 * bflo(bq[e]) + w2 * bflo(cq[e]); o[8 * j + 2 * e + 1] = w0 * bfhi(a[e]) + w1 * bfhi(bq[e]) + w2 * bfhi(cq[e]); } }
#pragma unroll
    for (int d = 0; d < 16; ++d) ss += o[d] * o[d];
    ss += sx(ss, 1, lane); ss += sx(ss, 2, lane); ss += sx(ss, 4, lane);
    rn = 1.0f / sqrtf(ss * (1.f / 128.f) + RMS_EPS);
}
__device__ __forceinline__ void dil_combine_store(const float (&o)[16], float rn, bf16_t* xo, const float* g_dil, int lane) {
    const int h = lane >> 3, seg = lane & 7; const int off = h * 128 + seg * 16;
#pragma unroll
    for (int j = 0; j < 2; ++j) { u32x4 w;
#pragma unroll
        for (int e = 0; e < 4; ++e) w[e] = pk2(o[8 * j + 2 * e] * rn * g_dil[seg * 16 + 8 * j + 2 * e], o[8 * j + 2 * e + 1] * rn * g_dil[seg * 16 + 8 * j + 2 * e + 1]);
        *(u32x4*)(xo + off + 8 * j) = w; }
}

#define XB_TMO      128
#define XB_XCNT(j)  (256  + 64 * (j))
#define XB_XSUB(j)  (1280 + 64 * (j))
#define XB_XGEN(j)  (2304 + 64 * (j))
#define XB_TOP      3328
#define XB_TOPGEN   3392
#define XCD_BAR_WORDS 3456
#define XB_SPIN_CAP (1u << 22)

__device__ __forceinline__ unsigned xb_ld(unsigned* p)              { return __hip_atomic_load(p, __ATOMIC_RELAXED, __HIP_MEMORY_SCOPE_AGENT); }
__device__ __forceinline__ unsigned xb_add(unsigned* p, unsigned v) { return __hip_atomic_fetch_add(p, v, __ATOMIC_RELAXED, __HIP_MEMORY_SCOPE_AGENT); }
__device__ __forceinline__ unsigned xb_xcc_id() { return (unsigned)__builtin_amdgcn_s_getreg((3 << 11) | 20) & 0xFu; }
#define XB_SPIN(cond, bar) do { unsigned _sp = 0; while (cond) { __builtin_amdgcn_s_sleep(1); \
    if ((++_sp & 255u) == 0u) { if (xb_ld(&(bar)[XB_TMO])) break; if (_sp > XB_SPIN_CAP) { atomicAdd(&(bar)[XB_TMO], 1u); break; } } } } while (0)

struct XcdBarrier {
    unsigned* bar; unsigned x;
    volatile LAS unsigned* st;
};

__device__ __forceinline__ XcdBarrier xcd_barrier_post(unsigned* bar, volatile LAS unsigned* st) {
    XcdBarrier b; b.bar = bar; b.x = xb_xcc_id(); b.st = st;
    if (threadIdx.x == 0) (void)xb_add(&bar[XB_XCNT(b.x)], 1u);
    return b;
}
__device__ __forceinline__ void xcd_barrier_complete(unsigned* bar, unsigned x, unsigned& nloc, unsigned& nx) {
    const unsigned G = gridDim.x * gridDim.y * gridDim.z;
    unsigned sum, cnt, mine, sp = 0u;
    for (;;) {
        sum = 0u; cnt = 0u; mine = 0u;
#pragma unroll
        for (unsigned j = 0; j < 16; ++j) { const unsigned c = xb_ld(&bar[XB_XCNT(j)]); sum += c; cnt += (c > 0u) ? 1u : 0u; mine = (j == x) ? c : mine; }
        if (sum == G) break;
        __builtin_amdgcn_s_sleep(1);
        if ((++sp & 255u) == 0u) { if (xb_ld(&bar[XB_TMO])) break; if (sp > XB_SPIN_CAP) { atomicAdd(&bar[XB_TMO], 1u); break; } }
    }
    nloc = mine > 0u ? mine : 1u; nx = cnt > 0u ? cnt : 1u;
}

__device__ __forceinline__ void xcd_barrier(const XcdBarrier& b) {
    asm volatile("s_waitcnt vmcnt(0)" ::: "memory");
    __syncthreads();
    if (threadIdx.x == 0) {
        unsigned* bar = b.bar;
        __builtin_amdgcn_s_waitcnt(0);
        unsigned nloc = b.st[0], nx = b.st[1];
        if (nloc == 0u) { xcd_barrier_complete(bar, b.x, nloc, nx); b.st[0] = nloc; b.st[1] = nx; }
        const unsigned old = xb_add(&bar[XB_XSUB(b.x)], 1u);
        const unsigned gen = old / nloc;
        if (old + 1u == (gen + 1u) * nloc) {
            __builtin_amdgcn_fence(__ATOMIC_RELEASE, "agent");
            asm volatile("s_waitcnt vmcnt(0)" ::: "memory");
            const unsigned og = xb_add(&bar[XB_TOP], 1u);
            const unsigned tg = og / nx;
            if (og + 1u == (tg + 1u) * nx) xb_add(&bar[XB_TOPGEN], 1u);
            else XB_SPIN(xb_ld(&bar[XB_TOPGEN]) == tg, bar);
            __builtin_amdgcn_fence(__ATOMIC_ACQUIRE, "agent");
            xb_add(&bar[XB_XGEN(b.x)], 1u);
            asm volatile("s_waitcnt vmcnt(0)" ::: "memory");
        } else {
            XB_SPIN(xb_ld(&bar[XB_XGEN(b.x)]) == gen, bar);
            __builtin_amdgcn_fence(__ATOMIC_ACQUIRE, "agent");
            asm volatile("s_waitcnt vmcnt(0)" ::: "memory");
        }
    }
    __syncthreads();
}

constexpr int NWAVES = 8;
constexpr int GRID_BLOCKS = 256;
constexpr int LDS_BYTES = 155648;

__global__ void __launch_bounds__(NWAVES * 64, 2) mega_fwd(Params P) {
    extern __shared__ __attribute__((aligned(16))) unsigned char lds_raw[];
    LAS unsigned char* lds = (LAS unsigned char*)lds_raw;
    cg::grid_group grid = cg::this_grid();
    const int wave = __builtin_amdgcn_readfirstlane((int)threadIdx.x >> 6);
    constexpr int G = GRID_BLOCKS; const int bx = blockIdx.x;
    const int gw = bx * NWAVES + wave, NGW = G * NWAVES;
    const int NGT = G * NWAVES * 64;
#define PH_IDS int lane_; asm volatile("v_mbcnt_lo_u32_b32 %0, -1, 0\n\tv_mbcnt_hi_u32_b32 %0, -1, %0" : "=v"(lane_)); const int lane = lane_; const int tid_ = wave * 64 + lane_; const int gt = bx * (NWAVES * 64) + tid_; (void)lane; (void)gt; (void)tid_;
    unsigned char* ws = P.ws;
    const float* x = P.in[0]; const float* mem = P.in[1];
    bf16_t* Wl = (bf16_t*)(ws + WS_W);
    bf16_t* XB = (bf16_t*)(ws + WS_XB); bf16_t* XBB = (bf16_t*)(ws + WS_XBB);
    bf16_t* BIG = (bf16_t*)(ws + WS_BIG);
    bf16_t* MEMB = (bf16_t*)(ws + WS_MEMB); bf16_t* KMEM = (bf16_t*)(ws + WS_KMEM); bf16_t* VT = (bf16_t*)(ws + WS_VT);
    float* RAWH = (float*)(ws + WS_RAWH); float* RAWT = (float*)(ws + WS_RAWT); float* RSUM = (float*)(ws + WS_RSUM);
    float* H = P.out;
    volatile LAS unsigned* bar_st = (volatile LAS unsigned*)(lds + LDS_BYTES - 64);
    if (threadIdx.x < 2) bar_st[threadIdx.x] = 0u;
    __syncthreads();
    XcdBarrier xbar = xcd_barrier_post((unsigned*)ws, bar_st);
#define GRID_SYNC() xcd_barrier(xbar)
    float* IDENT = (float*)(ws + WS_IDENT); float* STATS = (float*)(ws + WS_STATS);
    float* CSF = (float*)(ws + WS_CSF); float* BWF = CSF + NCOLS;
    float* CSP = (float*)(ws + WS_BIG + 64 * MiB);
    bf16_t* WKV = BIG;
    bf16_t* PART0 = (bf16_t*)(ws + WS_RAWH); bf16_t* PART1 = (bf16_t*)(ws + WS_PART1); float* LSE = (float*)(ws + WS_LSE);
#define PSTAT(i) ((float*)(ws + WS_PSTAT + (size_t)(i) * 8 * MiB))

#pragma unroll 1
    for (int l = 0; l < NLAYER; ++l) {
        {
            PH_IDS
            LAS float* scr = (LAS float*)(lds + wave * 17408);
            if (l == 0) {
                for (int i = gt; i < 2 * DM; i += NGT) IDENT[i] = i < DM ? 1.f : 0.f;
                for (size_t i = gt; i < (size_t)TOK * DM / 4; i += (size_t)NGT * 8) { f32x4 v[8];
#pragma unroll
                    for (int j = 0; j < 8; ++j) v[j] = ((const f32x4*)x)[i + (size_t)j * NGT];
#pragma unroll
                    for (int j = 0; j < 8; ++j) { u32x2 w; w.x = pk2(v[j][0], v[j][1]); w.y = pk2(v[j][2], v[j][3]); ((u32x2*)XBB)[i + (size_t)j * NGT] = w; } }
                for (size_t i = gt; i < (size_t)MEMT * DM / 4; i += (size_t)NGT * 8) { f32x4 v[8];
#pragma unroll
                    for (int j = 0; j < 8; ++j) v[j] = ((const f32x4*)mem)[i + (size_t)j * NGT];
#pragma unroll
                    for (int j = 0; j < 8; ++j) { u32x2 w; w.x = pk2(v[j][0], v[j][1]); w.y = pk2(v[j][2], v[j][3]); ((u32x2*)MEMB)[i + (size_t)j * NGT] = w; } }
                for (int i = gt; i < 2 * TOK; i += NGT) STATS[i] = (float)(i & 1);
            }
#pragma unroll 1
            for (int k = 0; k < 8; ++k) {
                if (k >= 6 && l != 0) break;
                const float* src; int K, N, mode = 0; bf16_t* dst; const float* gv = nullptr; const float* bv = nullptr; float* csp = nullptr;
                if (k == 0)      { src = P.in[2]  + (size_t)l * DM * NIN;  K = DM;  N = NIN; dst = Wl + WO_IN;  csp = CSP + (size_t)CB_IN * 2; }
                else if (k == 1) { src = P.in[3]  + (size_t)l * DM * DM;   K = DM;  N = DM;  dst = Wl + WO_OUT; }
                else if (k == 2) { src = P.in[12] + (size_t)l * DM * DM;   K = DM;  N = DM;  dst = Wl + WO_Q;   gv = P.in[10] + l * DM; bv = P.in[11] + l * DM; csp = CSP + (size_t)CB_Q * 2; }
                else if (k == 3) { src = P.in[14] + (size_t)l * DM * DM;   K = DM;  N = DM;  dst = Wl + WO_O; }
                else if (k == 4) { src = P.in[17] + (size_t)l * DM * NUP;  K = DM;  N = NUP; dst = Wl + WO_UP;  mode = 1; gv = P.in[15] + l * DM; bv = P.in[16] + l * DM; csp = CSP + (size_t)CB_UP * 2; }
                else if (k == 5) { src = P.in[20] + (size_t)l * DFF * DM;  K = DFF; N = DM;  dst = Wl + WO_DN; }
                else             { src = P.in[13] + (size_t)(k - 6) * DM * 2 * DM; K = DM; N = 2 * DM; dst = WKV + (size_t)(k - 6) * 2 * DM * DM; }
                if (k == 0 && l != 0) { gv = P.in[21] + (l - 1) * DM; bv = P.in[22] + (l - 1) * DM; }
                const int nblk = N >> 6, nmagic = N == NIN ? 10923 : (N == DM ? 32768 : (N == NUP ? 5958 : 16384));
                const int items = (K >> 6) * nblk;
                for (int it = gw; it < items; it += NGW) transpose_item(src, K, N, dst, mode, scr, it, lane, gv, bv, csp, nblk, nmagic);
            }
        }
        __syncthreads();
        if (l == 0) grid.sync(); else GRID_SYNC();
        {
            PH_IDS
            for (int col = gt; col < NCOLS; col += NGT) { float cs = 0.f, bs = 0.f;
#pragma unroll 8
                for (int kb = 0; kb < 32; ++kb) { const f32x2 v = *(const f32x2*)(CSP + ((size_t)kb * NCOLS + col) * 2); cs += v[0]; bs += v[1]; }
                CSF[col] = cs; BWF[col] = bs; }
        }
        if (l == 0) {
            pg8::Gemm g{(const bf16_t*)ws, (const bf16_t*)ws, DM, DM, DM};
            pg8::SchedKV S{G, ((bx & 7) * (G / 8)) + (bx >> 3), (long)WS_MEMB, (long)WS_BIG, (long)(WS_BIG + (size_t)2 * DM * DM * 2)};
            pg8::EpiBf16Sel E{KMEM, VT, (bf16_t*)(ws + WS_KV1), (bf16_t*)(ws + WS_KV1 + 16 * MiB)};
            pg8::gemm_phase(lds, g, S, E, wave);
        }
        __syncthreads();
        GRID_SYNC();

        const bf16_t* KMl = l == 0 ? KMEM : (const bf16_t*)(ws + WS_KV1); const bf16_t* VTl = l == 0 ? VT : (const bf16_t*)(ws + WS_KV1 + 16 * MiB);
        const float lam_init = 0.8f - 0.6f * __expf(-0.3f * (float)l);
        {
            pg8::Gemm g{XBB, Wl + WO_IN, DM, DM, DM}; pg8::Sched2D S; S.init(TOK, NIN, DM, DM, G, bx);
            pg8::EpiBf16A E{BIG, NIN, STATS, CSF + CB_IN, BWF + CB_IN};
            pg8::gemm_phase(lds, g, S, E, wave);
        }
        GRID_SYNC();
        {
            PH_IDS
            const float a1 = wave_sum(P.in[4][l * 64 + lane] * P.in[5][l * 64 + lane], lane);
            const float a2 = wave_sum(P.in[6][l * 64 + lane] * P.in[7][l * 64 + lane], lane);
            const float lam = __int_as_float(__builtin_amdgcn_readfirstlane(__float_as_int(__expf(a1) - __expf(a2) + lam_init)));
            const float* gdf = P.in[8] + l * 128;
            LAS unsigned char* vl = lds + wave * WAVE_LDS;
            const int vgw = (((bx & 7) * (G / 8)) + (bx >> 3)) * NWAVES + wave;
            for (int task = vgw; task < NB * 8 * 32; task += NGW) {
                const int bh = task >> 5, pp = task & 31;
                diff_task(BIG, XB, bh >> 3, bh & 7, pp, lam, 1.f - lam_init, gdf, lane, vl);
                diff_task(BIG, XB, bh >> 3, bh & 7, 63 - pp, lam, 1.f - lam_init, gdf, lane, vl);
            }
            for (int task = vgw; task < 3 * NB * 8 * 64; task += NGW) {
                const int br = task / (NB * 8 * 64), rem = task % (NB * 8 * 64), bh = rem >> 6;
                const int idx = ((rem & 63) + 16 * ((rem >> 11) & 3)) & 63;
                const int dil = br == 0 ? 1 : (br == 1 ? 4 : 16);
                const int c = idx & (dil - 1), pb = idx / dil;
                bf16_t* po = br == 0 ? PART0 : (br == 1 ? PART1 : XB + 1024);
                dil_task(BIG, po, br == 2 ? DM : 1024, LSE + (size_t)br * TOK * 8, bh >> 3, bh & 7, dil, c, pb, lane, vl);
            }
        }
        __syncthreads();
        GRID_SYNC();
        { PH_IDS
          const float* gdl = P.in[9] + l * 128;
          for (int m = gw; m < TOK; m += 4 * NGW) { float o[4][16], rn[4];
#pragma unroll
              for (int j = 0; j < 4; ++j) { const int mm = m + j * NGW; dil_combine_load(o[j], rn[j], PART0 + (size_t)mm * 1024, PART1 + (size_t)mm * 1024, XB + (size_t)mm * DM + 1024, LSE + (size_t)mm * 8, LSE + (size_t)(TOK + mm) * 8, LSE + (size_t)(2 * TOK + mm) * 8, lane); }
#pragma unroll
              for (int j = 0; j < 4; ++j) { const int mm = m + j * NGW; dil_combine_store(o[j], rn[j], XB + (size_t)mm * DM + 1024, gdl, lane); } } }
        __syncthreads();
        GRID_SYNC();
        {
            pg8::Gemm g{XB, Wl + WO_OUT, DM, DM, DM}; pg8::Sched2D S; S.init(TOK, DM, DM, DM, G, bx);
            pg8::EpiResid<false> E{H, XBB, STATS, PSTAT(0), l == 0 ? IDENT : P.in[21] + (l - 1) * DM, l == 0 ? IDENT + DM : P.in[22] + (l - 1) * DM};
            pg8::gemm_phase(lds, g, S, E, wave);
        }
        GRID_SYNC();
        { PH_IDS
          const int fr = lane & 15, fq = lane >> 4; const int row = gw * 16 + fr; float mu, rs;
          pg8::row_stats(PSTAT(0) + (size_t)row * 64, fq, lane, mu, rs);
          if (fq == 0) { f32x2 o2; o2[0] = mu; o2[1] = rs; ((f32x2*)STATS)[row] = o2; } }
        __syncthreads();
        GRID_SYNC();
        bf16_t* QM = BIG; bf16_t* PM = BIG + (size_t)TOK * DM;
        {
            pg8::Gemm g{XBB, Wl + WO_Q, DM, DM, DM}; pg8::Sched2D S; S.init(TOK, DM, DM, DM, G, bx);
            pg8::EpiBf16A E{QM, DM, STATS, CSF + CB_Q, BWF + CB_Q};
            pg8::gemm_phase(lds, g, S, E, wave);
        }
        GRID_SYNC();
        {
            pg8::Gemm g{QM, KMl, DM, DM, 512}; pg8::SchedScores S{G, ((bx & 7) * (G / 8)) + (bx >> 3)};
            pg8::EpiExp E{PM, RSUM, 0.04419417382415922f};
            pg8::gemm_phase(lds, g, S, E, wave);
        }
        GRID_SYNC();
        {
            pg8::Gemm g{PM, VTl, 1024, MEMT, 256}; pg8::SchedPV S{G, ((bx & 7) * (G / 8)) + (bx >> 3)};
            pg8::EpiDivRow E{XB, RSUM};
            pg8::gemm_phase(lds, g, S, E, wave);
        }
        GRID_SYNC();
        {
            pg8::Gemm g{XB, Wl + WO_O, DM, DM, DM}; pg8::Sched2D S; S.init(TOK, DM, DM, DM, G, bx);
            pg8::EpiResid<false> E{H, XBB, STATS, PSTAT(0), P.in[10] + l * DM, P.in[11] + l * DM};
            pg8::gemm_phase(lds, g, S, E, wave);
        }
        GRID_SYNC();
        { PH_IDS
          const int fr = lane & 15, fq = lane >> 4; const int row = gw * 16 + fr; float mu, rs;
          pg8::row_stats(PSTAT(0) + (size_t)row * 64, fq, lane, mu, rs);
          if (fq == 0) { f32x2 o2; o2[0] = mu; o2[1] = rs; ((f32x2*)STATS)[row] = o2; } }
        __syncthreads();
        GRID_SYNC();
        const float* cw = P.in[18] + (size_t)l * 3 * NUP; const float* cb = P.in[19] + (size_t)l * NUP;
        {
            pg8::Gemm g{XBB, Wl + WO_UP, DM, DM, DM}; pg8::Sched2D S; S.init(TOK, NUP, DM, DM, G, bx);
            pg8::EpiConvGate E{BIG, RAWH, RAWT, cw, cb, STATS, CSF + CB_UP, BWF + CB_UP};
            pg8::gemm_phase(lds, g, S, E, wave);
        }
        GRID_SYNC();
        { PH_IDS
        for (int idx = gt; idx < 512 * 2 * (DFF / 4); idx += NGT) {
            const int c4 = idx % (DFF / 4), r = (idx / (DFF / 4)) & 1, run = idx / (2 * (DFF / 4)), ch = c4 * 4;
            const bool first = (run % 32) == 0;
            f32x4 cv[2];
#pragma unroll
            for (int bj = 0; bj < 2; ++bj) {
                const f32x4 z = (f32x4){0.f, 0.f, 0.f, 0.f};
                const f32x4 h0 = *(const f32x4*)(RAWH + ((size_t)(run * 2 + r) * 2 + bj) * DFF + ch);
                const f32x4 t1 = first ? z : *(const f32x4*)(RAWT + ((size_t)((run - 1) * 2 + 1) * 2 + bj) * DFF + ch);
                const f32x4 t0 = first ? z : *(const f32x4*)(RAWT + ((size_t)((run - 1) * 2 + 0) * 2 + bj) * DFF + ch);
                const f32x4 hh0 = *(const f32x4*)(RAWH + ((size_t)(run * 2 + 0) * 2 + bj) * DFF + ch);
                const f32x4 h1 = (r == 1) ? hh0 : t1, h2 = (r == 1) ? t1 : t0;
                const int cidx = bj * DFF + ch;
                const f32x4 w0 = *(const f32x4*)(cw + cidx), w1 = *(const f32x4*)(cw + NUP + cidx), w2 = *(const f32x4*)(cw + 2 * NUP + cidx), bb = *(const f32x4*)(cb + cidx);
                cv[bj] = w2 * h0 + w1 * h1 + w0 * h2 + bb;
            }
            f32x4 o;
#pragma unroll
            for (int e = 0; e < 4; ++e) o[e] = cv[0][e] / (1.0f + __expf(-cv[0][e])) * cv[1][e];
            u32x2 w; w.x = pk2(o[0], o[1]); w.y = pk2(o[2], o[3]);
            *(u32x2*)(BIG + (size_t)(run * 64 + r) * DFF + ch) = w;
        } }
        __syncthreads();
        GRID_SYNC();
        if (l < NLAYER - 1) {
            pg8::Gemm g{BIG, Wl + WO_DN, DFF, DFF, DFF}; pg8::Sched2D S; S.init(TOK, DM, DFF, DFF, G, bx);
            pg8::EpiResid<false> E{H, XBB, STATS, PSTAT(0), P.in[15] + l * DM, P.in[16] + l * DM};
            pg8::gemm_phase(lds, g, S, E, wave);
        } else {
            pg8::Gemm g{BIG, Wl + WO_DN, DFF, DFF, DFF}; pg8::Sched2D S; S.init(TOK, DM, DFF, DFF, G, bx);
            pg8::EpiResid<true> E{H, XBB, STATS, PSTAT(0), P.in[15] + l * DM, P.in[16] + l * DM};
            pg8::gemm_phase(lds, g, S, E, wave);
        }
        GRID_SYNC();
        if (l < NLAYER - 1) {
        { PH_IDS
          const int fr = lane & 15, fq = lane >> 4; const int row = gw * 16 + fr; float mu, rs;
          pg8::row_stats(PSTAT(0) + (size_t)row * 64, fq, lane, mu, rs);
          if (fq == 0) { f32x2 o2; o2[0] = mu; o2[1] = rs; ((f32x2*)STATS)[row] = o2; } }
        __syncthreads();
        GRID_SYNC();
        }
    }
    { PH_IDS
      for (int m = gw; m < TOK; m += NGW) ln_row(H + (size_t)m * DM, H + (size_t)m * DM, (bf16_t*)nullptr, P.in[21] + (NLAYER - 1) * DM, P.in[22] + (NLAYER - 1) * DM, lane); }
}

extern "C" void kernel_launch(void* const* d_in, const int* in_sizes, int n_in, void* d_out, int out_size, void* d_ws, size_t ws_size, hipStream_t stream) {
    static int grid = 0;
    if (grid == 0) {
        if (n_in != 23 || out_size != TOK * DM || ws_size < WS_END) { fprintf(stderr, "kernel_launch: unexpected problem (n_in %d, out %d, ws %zu)\n", n_in, out_size, ws_size); grid = -1; return; }
        int dev = 0, cus = 0, per_cu = 0;
        (void)hipGetDevice(&dev);
        (void)hipDeviceGetAttribute(&cus, hipDeviceAttributeMultiprocessorCount, dev);
        if (hipFuncSetAttribute((const void*)mega_fwd, hipFuncAttributeMaxDynamicSharedMemorySize, LDS_BYTES) != hipSuccess) { fprintf(stderr, "kernel_launch: hipFuncSetAttribute failed\n"); grid = -1; return; }
        if (hipOccupancyMaxActiveBlocksPerMultiprocessor(&per_cu, (const void*)mega_fwd, NWAVES * 64, LDS_BYTES) != hipSuccess || per_cu < 1) { fprintf(stderr, "kernel_launch: occupancy query says %d\n", per_cu); per_cu = 1; }
        (void)hipGetLastError();
        if (cus < GRID_BLOCKS) { fprintf(stderr, "kernel_launch: built for a %d-CU device, found %d\n", GRID_BLOCKS, cus); grid = -1; return; }
        grid = GRID_BLOCKS;
        fprintf(stderr, "kernel_launch: grid %d (cus %d, per_cu %d)\n", grid, cus, per_cu);
    }
    if (grid < 0) return;
    if (hipMemsetAsync(d_ws, 0, 65536, stream) != hipSuccess) { fprintf(stderr, "kernel_launch: hipMemsetAsync failed\n"); return; }
    Params p{};
    for (int i = 0; i < 23; ++i) p.in[i] = (const float*)d_in[i];
    p.out = (float*)d_out; p.ws = (unsigned char*)d_ws;
    void* args[] = {&p};
    hipError_t e = hipLaunchCooperativeKernel((const void*)mega_fwd, dim3(grid), dim3(NWAVES * 64), args, LDS_BYTES, stream);
    if (e != hipSuccess) fprintf(stderr, "kernel_launch: cooperative launch failed: %s (grid %d)\n", hipGetErrorString(e), grid);
}
```
